# Optimizing an MI355X kernel written in HIP

```python
import math
import jax, jax.numpy as jnp
from jax import lax
import numpy as np

D_MODEL = 2048
BATCH = 8
SEQ = 2048
DEPTH = 2

HEAD_DIM = 64
BLOCK = 128
A_Q_HEADS = 12
A_KV_HEADS = 4
A_GROUP = A_Q_HEADS // A_KV_HEADS
WINDOW = 128
B_HEADS = 4
C_HEADS = 12
A_WIDTH = A_Q_HEADS * HEAD_DIM
B_WIDTH = B_HEADS * 2 * HEAD_DIM
C_WIDTH = C_HEADS * HEAD_DIM
N_BRANCH = 3
IN_SPLITS = (A_WIDTH, A_KV_HEADS * HEAD_DIM, A_KV_HEADS * HEAD_DIM,
             B_WIDTH, B_WIDTH, B_WIDTH,
             C_WIDTH, C_WIDTH, C_WIDTH, C_HEADS,
             N_BRANCH * D_MODEL)
D_IN = sum(IN_SPLITS)
D_FF = ((8 * D_MODEL // 3 + 255) // 256) * 256
N_EXPERTS = 8
TOP_K = 2
D_FF_EXPERT = 7 * D_MODEL // 2
N_DENSE = (DEPTH + 1) // 2
N_MOE = DEPTH // 2
RMS_EPS = 1e-6
NEG_INF = -1e30

kernel_name = "hybrid_gated_swa_diff_fox_moe"


def rmsnorm(x, g):
    xf = x.astype(jnp.float32)
    xf = xf * lax.rsqrt(jnp.mean(xf * xf, axis=-1, keepdims=True) + RMS_EPS)
    return xf.astype(x.dtype) * g


def alibi_slopes(n):
    return jnp.exp2(-8.0 * (jnp.arange(n, dtype=jnp.float32) + 1.0) / n)


def split_cols(z, sizes):
    offs = np.cumsum(np.array(sizes))[:-1].tolist()
    return jnp.split(z, offs, axis=-1)


def window_attention_sinks(q, k, v, sinks, slopes):
    b, s, hq, d = q.shape
    hkv = k.shape[2]
    g = hq // hkv
    nb = s // BLOCK
    qb = q.reshape(b, nb, BLOCK, hkv, g, d)
    k_cur = k.reshape(b, nb, BLOCK, hkv, d)
    v_cur = v.reshape(b, nb, BLOCK, hkv, d)
    pad = ((0, 0), (1, 0), (0, 0), (0, 0), (0, 0))
    kb = jnp.concatenate([jnp.pad(k_cur, pad)[:, :-1], k_cur], axis=2)
    vb = jnp.concatenate([jnp.pad(v_cur, pad)[:, :-1], v_cur], axis=2)
    logits = jnp.einsum('bnqhgd,bnkhd->bnhgqk', qb, kb).astype(jnp.float32) * (d ** -0.5)
    dist = jnp.arange(BLOCK)[:, None] + BLOCK - jnp.arange(2 * BLOCK)[None, :]
    valid = (dist >= 0) & (dist < WINDOW)
    real = (jnp.arange(nb)[:, None] > 0) | (jnp.arange(2 * BLOCK)[None, :] >= BLOCK)
    mask = valid[None, :, :] & real[:, None, :]
    logits = logits - slopes.reshape(hkv, g, 1, 1) * dist.astype(jnp.float32)
    logits = jnp.where(mask[None, :, None, None], logits, NEG_INF)
    sink = jnp.broadcast_to(sinks.astype(jnp.float32).reshape(hkv, g, 1, 1), logits.shape[:-1] + (1,))
    p = jax.nn.softmax(jnp.concatenate([logits, sink], axis=-1), axis=-1)[..., :-1]
    o = jnp.einsum('bnhgqk,bnkhd->bnqhgd', p.astype(v.dtype), vb)
    return o.reshape(b, s, hq * d)


def diff_attention(q, k, v, lam, slopes):
    b, s, h, _, d = q.shape
    nb = s // BLOCK
    kpos = jnp.arange(s)

    def one_block(i):
        qi = lax.dynamic_slice_in_dim(q, i * BLOCK, BLOCK, axis=1)
        logits = jnp.einsum('bqhmd,bkhmd->bhmqk', qi, k).astype(jnp.float32) * (d ** -0.5)
        dist = (i * BLOCK + jnp.arange(BLOCK))[:, None] - kpos[None, :]
        logits = logits - slopes[:, None, None, None] * dist.astype(jnp.float32)
        logits = jnp.where(dist >= 0, logits, NEG_INF)
        p = jax.nn.softmax(logits, axis=-1)
        a = p[:, :, 0] - lam * p[:, :, 1]
        return jnp.einsum('bhqk,bkhe->bqhe', a.astype(v.dtype), v)

    o = lax.map(one_block, jnp.arange(nb))
    return o.transpose(1, 0, 2, 3, 4).reshape(b, s, h, 2 * d)


def forgetting_attention(q, k, v, log_f):
    b, s, h, d = q.shape
    nb = s // BLOCK
    c = jnp.cumsum(log_f, axis=1).transpose(0, 2, 1)
    kpos = jnp.arange(s)

    def one_block(i):
        qi = lax.dynamic_slice_in_dim(q, i * BLOCK, BLOCK, axis=1)
        ci = lax.dynamic_slice_in_dim(c, i * BLOCK, BLOCK, axis=2)
        logits = jnp.einsum('bqhd,bkhd->bhqk', qi, k).astype(jnp.float32) * (d ** -0.5)
        logits = logits + ci[:, :, :, None] - c[:, :, None, :]
        causal = (i * BLOCK + jnp.arange(BLOCK))[:, None] >= kpos[None, :]
        logits = jnp.where(causal, logits, NEG_INF)
        p = jax.nn.softmax(logits, axis=-1)
        return jnp.einsum('bhqk,bkhd->bqhd', p.astype(v.dtype), v)

    o = lax.map(one_block, jnp.arange(nb))
    return o.transpose(1, 0, 2, 3, 4).reshape(b, s, h * d)


def token_mixer(h, w_in, b_forget, b_gate, sinks, lq1, lk1, lq2, lk2, subln,
                w_br_a, w_br_b, w_br_c, w_out, layer_idx):
    b, s, _ = h.shape
    z = h @ w_in
    qa, ka, va, qb, kb, vb, qc, kc, vc, fc, gt = split_cols(z, IN_SPLITS)
    oa = window_attention_sinks(qa.reshape(b, s, A_Q_HEADS, HEAD_DIM),
                                ka.reshape(b, s, A_KV_HEADS, HEAD_DIM),
                                va.reshape(b, s, A_KV_HEADS, HEAD_DIM),
                                sinks, alibi_slopes(A_Q_HEADS))
    lam_init = 0.8 - 0.6 * math.exp(-0.3 * layer_idx)
    lam = (jnp.exp(jnp.sum(lq1.astype(jnp.float32) * lk1.astype(jnp.float32)))
           - jnp.exp(jnp.sum(lq2.astype(jnp.float32) * lk2.astype(jnp.float32))) + lam_init)
    ob = diff_attention(qb.reshape(b, s, B_HEADS, 2, HEAD_DIM),
                        kb.reshape(b, s, B_HEADS, 2, HEAD_DIM),
                        vb.reshape(b, s, B_HEADS, 2 * HEAD_DIM),
                        lam, alibi_slopes(B_HEADS))
    ob = (rmsnorm(ob, subln) * (1.0 - lam_init)).reshape(b, s, B_WIDTH)
    log_f = jax.nn.log_sigmoid((fc + b_forget).astype(jnp.float32))
    oc = forgetting_attention(qc.reshape(b, s, C_HEADS, HEAD_DIM),
                              kc.reshape(b, s, C_HEADS, HEAD_DIM),
                              vc.reshape(b, s, C_HEADS, HEAD_DIM), log_f)
    gates = jax.nn.sigmoid((gt + b_gate).astype(jnp.float32)).astype(h.dtype)
    gates = gates.reshape(b, s, N_BRANCH, D_MODEL)
    merged = (gates[:, :, 0] * (oa @ w_br_a) + gates[:, :, 1] * (ob @ w_br_b)
              + gates[:, :, 2] * (oc @ w_br_c))
    return merged @ w_out


def swiglu(h, wg, wu, wd):
    return (jax.nn.silu(h @ wg) * (h @ wu)) @ wd


def moe_swiglu(h, w_router, e_gate, e_up, e_down):
    b, s, dm = h.shape
    t = h.reshape(b * s, dm)
    logits = (t @ w_router).astype(jnp.float32)
    top_val, top_idx = lax.top_k(logits, TOP_K)
    top_w = jax.nn.softmax(top_val, axis=-1)
    gates = jnp.sum(jax.nn.one_hot(top_idx, N_EXPERTS, dtype=jnp.float32) * top_w[..., None], axis=1)
    y = jnp.zeros_like(t)
    for e in range(N_EXPERTS):
        y = y + gates[:, e:e + 1].astype(t.dtype) * swiglu(t, e_gate[e], e_up[e], e_down[e])
    return y.reshape(b, s, dm)


def setup_inputs(seed: int = 0) -> dict:
    key = jax.random.key(seed)
    ks = iter(jax.random.split(key, 32))

    def nrm(shape, scale):
        return jax.random.normal(next(ks), shape, jnp.float32) * scale

    def gain(shape):
        return 1.0 + nrm(shape, 0.02)

    return {
        "x": nrm((BATCH, SEQ, D_MODEL), 1.0),
        "mix_pre_norm": gain((DEPTH, D_MODEL)),
        "w_in": nrm((DEPTH, D_MODEL, D_IN), D_MODEL ** -0.5),
        "b_forget": 3.0 + nrm((DEPTH, C_HEADS), 0.5),
        "b_gate": nrm((DEPTH, N_BRANCH * D_MODEL), 0.02),
        "attn_sinks": nrm((DEPTH, A_Q_HEADS), 1.0),
        "lam_q1": nrm((DEPTH, HEAD_DIM), 0.1),
        "lam_k1": nrm((DEPTH, HEAD_DIM), 0.1),
        "lam_q2": nrm((DEPTH, HEAD_DIM), 0.1),
        "lam_k2": nrm((DEPTH, HEAD_DIM), 0.1),
        "diff_subln": gain((DEPTH, 2 * HEAD_DIM)),
        "w_br_a": nrm((DEPTH, A_WIDTH, D_MODEL), A_WIDTH ** -0.5),
        "w_br_b": nrm((DEPTH, B_WIDTH, D_MODEL), B_WIDTH ** -0.5),
        "w_br_c": nrm((DEPTH, C_WIDTH, D_MODEL), C_WIDTH ** -0.5),
        "w_out": nrm((DEPTH, D_MODEL, D_MODEL), D_MODEL ** -0.5),
        "mix_post_norm": gain((DEPTH, D_MODEL)),
        "ffn_pre_norm": gain((DEPTH, D_MODEL)),
        "ffn_post_norm": gain((DEPTH, D_MODEL)),
        "dense_w_gate": nrm((N_DENSE, D_MODEL, D_FF), D_MODEL ** -0.5),
        "dense_w_up": nrm((N_DENSE, D_MODEL, D_FF), D_MODEL ** -0.5),
        "dense_w_down": nrm((N_DENSE, D_FF, D_MODEL), D_FF ** -0.5),
        "w_router": nrm((N_MOE, D_MODEL, N_EXPERTS), D_MODEL ** -0.5),
        "moe_w_gate": nrm((N_MOE, N_EXPERTS, D_MODEL, D_FF_EXPERT), D_MODEL ** -0.5),
        "moe_w_up": nrm((N_MOE, N_EXPERTS, D_MODEL, D_FF_EXPERT), D_MODEL ** -0.5),
        "moe_w_down": nrm((N_MOE, N_EXPERTS, D_FF_EXPERT, D_MODEL), D_FF_EXPERT ** -0.5),
    }


def reference(x, mix_pre_norm, w_in, b_forget, b_gate, attn_sinks, lam_q1, lam_k1,
              lam_q2, lam_k2, diff_subln, w_br_a, w_br_b, w_br_c, w_out,
              mix_post_norm, ffn_pre_norm, ffn_post_norm, dense_w_gate, dense_w_up,
              dense_w_down, w_router, moe_w_gate, moe_w_up, moe_w_down):
    for l in range(DEPTH):
        h = rmsnorm(x, mix_pre_norm[l])
        m = token_mixer(h, w_in[l], b_forget[l], b_gate[l], attn_sinks[l],
                        lam_q1[l], lam_k1[l], lam_q2[l], lam_k2[l], diff_subln[l],
                        w_br_a[l], w_br_b[l], w_br_c[l], w_out[l], l)
        x = x + rmsnorm(m, mix_post_norm[l])
        h = rmsnorm(x, ffn_pre_norm[l])
        if l % 2 == 0:
            i = l // 2
            f = swiglu(h, dense_w_gate[i], dense_w_up[i], dense_w_down[i])
        else:
            i = l // 2
            f = moe_swiglu(h, w_router[i], moe_w_gate[i], moe_w_up[i], moe_w_down[i])
        x = x + rmsnorm(f, ffn_post_norm[l])
    return x
```

```cpp
#include <hip/hip_runtime.h>
#include <cstdio>
#include <cstdint>

#define LAS __attribute__((address_space(3)))
#define GAS __attribute__((address_space(1)))
typedef unsigned short bf16;
typedef short bf16x8 __attribute__((ext_vector_type(8)));
typedef short s16x4 __attribute__((ext_vector_type(4)));
typedef float f32x2 __attribute__((ext_vector_type(2)));
typedef float f32x4 __attribute__((ext_vector_type(4)));
typedef float f32x16 __attribute__((ext_vector_type(16)));
typedef unsigned u32x2 __attribute__((ext_vector_type(2)));
typedef unsigned u32x4 __attribute__((ext_vector_type(4)));

#ifndef MK_STOP_PHASE
#define MK_STOP_PHASE 99
#endif
#ifndef MK_FP8_GATES
#define MK_FP8_GATES 3
#endif
#ifndef MK_FP8_DDOWN
#define MK_FP8_DDOWN 1
#endif
#ifndef MK_PROBE_DUP
#define MK_PROBE_DUP 0
#endif
#ifndef MK_N_LAUNCHES
#define MK_N_LAUNCHES 1
#endif

constexpr int T_TOK = 16384, DM = 2048, SEQ = 2048, NBATCH = 8;
constexpr int ZP = 5120;
constexpr int GP = 6144;
constexpr int NIN = 11520;
constexpr int DIN_SRC = 11276;
constexpr int DFF = 5632, DFE = 7168, NEXP = 8;
constexpr int CAP = 16384;
constexpr int SLOT_ROWS = 32768 + 2048;
constexpr float RMS_EPS = 1e-6f;
constexpr float LOG2E = 1.4426950408889634f;
constexpr float QSCALE = 0.125f * LOG2E;

constexpr size_t MiB = 1u << 20;
constexpr size_t WS_CTL = 0, CTL_ZERO_BYTES = 1 * MiB;
constexpr size_t WS_WIN = 1 * MiB;
constexpr size_t WS_WBR = WS_WIN + 90 * MiB;
constexpr size_t WS_WOUT = WS_WBR + 16 * MiB;
constexpr size_t WS_WGU = WS_WOUT + 16 * MiB;
constexpr size_t WS_WD = WS_WGU + 44 * MiB;
constexpr size_t WS_EGU = WS_WD + 22 * MiB;
constexpr size_t WS_ED = WS_EGU + 448 * MiB;
constexpr size_t WS_H = WS_ED + 224 * MiB;
constexpr size_t WS_Z = WS_H + 64 * MiB;
constexpr size_t WS_G = WS_Z + 160 * MiB;
constexpr size_t WS_O = WS_G + 192 * MiB;
constexpr size_t WS_MG = WS_O + 64 * MiB;
constexpr size_t WS_U = WS_Z;
constexpr size_t WS_MO = WS_MG + 64 * MiB;
constexpr size_t WS_Y = WS_MO + 64 * MiB;
constexpr size_t WS_LF = WS_Y + 136 * MiB;
constexpr size_t WS_LIST = WS_LF + 1 * MiB;
constexpr size_t WS_TOK = WS_LIST + 512 * 1024;
constexpr size_t WS_XB = WS_TOK + 512 * 1024;
constexpr size_t WS_H8 = WS_XB + 64 * MiB;
constexpr size_t WS_END = WS_H8 + 32 * MiB;
static_assert((size_t)SLOT_ROWS * DFE * 2 <= 480 * MiB, "MoE hidden fits the overlay");
constexpr int CW_TMO = 0, CW_CODE = 1;
constexpr int CW_BAR = 4096;
constexpr int CW_ATTQ = 8192;
constexpr int CW_ECNT = 8192 + 256;

constexpr int RING_OFF = 0, RING_BYTES = 131072;
constexpr int LDSCTL_OFF = RING_BYTES, MISC_OFF = LDSCTL_OFF + 320;
constexpr int LDS_BYTES = 155648;
constexpr int NWAVES = 8;

typedef __bf16 bf16x2_t __attribute__((ext_vector_type(2)));
__device__ __forceinline__ unsigned cvt_pk_bf16(float lo, float hi) { const f32x2 v = {lo, hi}; const bf16x2_t b = __builtin_convertvector(v, bf16x2_t); return __builtin_bit_cast(unsigned, b); }
__device__ __forceinline__ float bf_lo(unsigned w) { return __builtin_bit_cast(float, w << 16); }
__device__ __forceinline__ float bf_hi(unsigned w) { return __builtin_bit_cast(float, w & 0xffff0000u); }
template <int X> __device__ __forceinline__ float swz_xor(float v) { return __int_as_float(__builtin_amdgcn_ds_swizzle(__float_as_int(v), 0x1f | (X << 10))); }
__device__ __forceinline__ float wave_sum(float v) {
    v += swz_xor<1>(v); v += swz_xor<2>(v); v += swz_xor<4>(v); v += swz_xor<8>(v); v += swz_xor<16>(v);
    const auto rr = __builtin_amdgcn_permlane32_swap(__float_as_uint(v), __float_as_uint(v), false, false);
    return __uint_as_float(rr[0]) + __uint_as_float(rr[1]);
}
__device__ __forceinline__ float wave_incl_scan(float v, int lane, float& total) {
    float pre = v, tot = v, t;
    t = swz_xor<1>(tot);  if (lane & 1)  pre += t; tot += t;
    t = swz_xor<2>(tot);  if (lane & 2)  pre += t; tot += t;
    t = swz_xor<4>(tot);  if (lane & 4)  pre += t; tot += t;
    t = swz_xor<8>(tot);  if (lane & 8)  pre += t; tot += t;
    t = swz_xor<16>(tot); if (lane & 16) pre += t; tot += t;
    const auto rr = __builtin_amdgcn_permlane32_swap(__float_as_uint(tot), __float_as_uint(tot), false, false);
    if (lane & 32) pre += __uint_as_float(rr[0]);
    total = __uint_as_float(rr[0]) + __uint_as_float(rr[1]);
    return pre;
}
__device__ __forceinline__ unsigned pack4_fp8(float a, float b, float c, float d) {
    a = fminf(fmaxf(a, -448.f), 448.f); b = fminf(fmaxf(b, -448.f), 448.f); c = fminf(fmaxf(c, -448.f), 448.f); d = fminf(fmaxf(d, -448.f), 448.f);
    int w = 0; w = __builtin_amdgcn_cvt_pk_fp8_f32(a, b, w, false); w = __builtin_amdgcn_cvt_pk_fp8_f32(c, d, w, true); return (unsigned)w; }
constexpr float F8_SWG = 64.f, F8_GT_INV = 1.f / 1024.f;
constexpr float F8_SY = 16.f;
constexpr float F8_SH = 16.f, F8_SWU = 64.f, F8_SU = 8.f, F8_SWD = 128.f, F8_UP_INV = 1.f / 1024.f, F8_DN_INV = 1.f / 1024.f;
typedef int v8i __attribute__((ext_vector_type(8)));
typedef short s16x16 __attribute__((ext_vector_type(16)));
__device__ __forceinline__ v8i cat8(bf16x8 a, bf16x8 b) { const s16x16 c = __builtin_shufflevector(a, b, 0, 1, 2, 3, 4, 5, 6, 7, 8, 9, 10, 11, 12, 13, 14, 15); return __builtin_bit_cast(v8i, c); }
__device__ __forceinline__ bf16x8 lo8(v8i v) { const s16x16 c = __builtin_bit_cast(s16x16, v); return __builtin_shufflevector(c, c, 0, 1, 2, 3, 4, 5, 6, 7); }
__device__ __forceinline__ bf16x8 hi8(v8i v) { const s16x16 c = __builtin_bit_cast(s16x16, v); return __builtin_shufflevector(c, c, 8, 9, 10, 11, 12, 13, 14, 15); }
__device__ __forceinline__ unsigned pack4_u8(float a, float b, float c, float d) {
    const float ta = fmaxf(__builtin_floorf(fmaf(a, 255.f, 0.5f)), 1.f), tb = fmaxf(__builtin_floorf(fmaf(b, 255.f, 0.5f)), 1.f), tc = fmaxf(__builtin_floorf(fmaf(c, 255.f, 0.5f)), 1.f), td = fmaxf(__builtin_floorf(fmaf(d, 255.f, 0.5f)), 1.f);
    return (unsigned)ta | ((unsigned)tb << 8) | ((unsigned)tc << 16) | ((unsigned)td << 24); }
__device__ __forceinline__ float ub(unsigned w, int k) { return (float)((w >> (8 * k)) & 0xffu); }
__device__ __forceinline__ float fast_sigmoid(float v) { return __builtin_amdgcn_rcpf(1.f + __builtin_amdgcn_exp2f(-LOG2E * v)); }

namespace pg8 {
constexpr int BM = 256, BK = 64, HALF = 128, HTB = HALF * BK * 2, STAGE_BYTES = 8 * HTB, NXCD = 8, WGM = 8;
__host__ __device__ __forceinline__ int lds_byte(int r, int c) { const int st = (r >> 4) * 2 + (c >> 5), rr = r & 15, cc = c & 31, ob = rr * 64 + cc * 2; return st * 1024 + (ob ^ (((ob >> 9) & 1) << 5)); }
__host__ __device__ __forceinline__ void stage_rc(int b, int& R, int& C) { const int st = b / 1024, sb = b % 1024, swz = sb ^ (((sb >> 9) & 1) << 5); R = (st >> 1) * 16 + swz / 64; C = (st & 1) * 32 + (swz % 64) / 2; }
__host__ __device__ __forceinline__ int perm32(int rho) { const int n = rho >> 4, i = rho & 15; return 8 * (i >> 2) + 4 * n + (i & 3); }

struct Unit { int pm, pn; };
struct Gemm { const bf16* A; const bf16* Bt; int K; };

struct StaticOrder {
    static constexpr bool GATHER = false;
    int nM, nN, nwg, G, c;
    __device__ __forceinline__ void init(int nM_, int nN_, int G_, int c_) { nM = nM_; nN = nN_; nwg = nM * nN; G = G_; c = c_; }
    __device__ __forceinline__ bool next(int i, Unit& u) const {
        const long L = (long)i * G + c; if (L >= nwg) return false;
        int wgid = (int)L; { const int q = nwg / NXCD, r = nwg % NXCD, xcd = wgid % NXCD, off = wgid / NXCD; wgid = (xcd < r ? xcd * (q + 1) : r * (q + 1) + (xcd - r) * q) + off; }
        const int nig = WGM * nN, gid = wgid / nig, fm = gid * WGM, gsz = (nM - fm) < WGM ? (nM - fm) : WGM;
        u.pm = fm + ((wgid % nig) % gsz); u.pn = (wgid % nig) / gsz; return true;
    }
    __device__ __forceinline__ int btile(const Unit& u) const { return u.pn; }
};
template <bool GATHER_> struct MoeOrder : StaticOrder {
    static constexpr bool GATHER = GATHER_;
    const LAS int* tbl; const int* list;
    __device__ __forceinline__ int expert(int pm) const { int e = 0;
#pragma unroll
        for (int j = 1; j < 8; ++j) e += (pm >= tbl[j]) ? 1 : 0;
        return __builtin_amdgcn_readfirstlane(e); }
    __device__ __forceinline__ int btile(const Unit& u) const { return expert(u.pm) * nN + u.pn; }
};

template <class Sched> __device__ __forceinline__ void a_offsets(const Sched& S, const Unit& u, const int (&RA)[2], const int (&CA)[2], int K, unsigned (&o)[2][2]) {
    if constexpr (Sched::GATHER) {
        const int e = S.expert(u.pm), lb = __builtin_amdgcn_readfirstlane((u.pm - S.tbl[e]) * 256), cnt = __builtin_amdgcn_readfirstlane(S.tbl[16 + e]); const int* lp = S.list + (size_t)e * CAP;
        int tok[2][2];
#pragma unroll
        for (int h = 0; h < 2; ++h)
#pragma unroll
            for (int i = 0; i < 2; ++i) { const int lr = lb + h * HALF + RA[i]; tok[h][i] = (lr < cnt) ? lp[lr] : 0; }
#pragma unroll
        for (int h = 0; h < 2; ++h)
#pragma unroll
            for (int i = 0; i < 2; ++i) o[h][i] = (unsigned)tok[h][i] * (unsigned)(K * 2) + (unsigned)(CA[i] * 2);
    }
}

typedef f32x4 Acc[2][2][4][2];

template <class Epi, class Sched, bool FP8 = false>
__device__ __forceinline__ void gemm_phase(int tid, LAS unsigned char* lds, const Gemm g, const Sched& S, const Epi& E) {
    const int wid = __builtin_amdgcn_readfirstlane(tid >> 6), lane = tid & 63, wr = wid >> 2, wc = wid & 3, fr = lane & 15, fq = lane >> 4;
    const int K = g.K, nt = K / BK;
    unsigned voffB[2], voffA[2]; int RA[2], CA[2];
#pragma unroll
    for (int i = 0; i < 2; ++i) { int R, C; stage_rc(tid * 16 + i * 8192, R, C); const int Rb = (R & ~31) + perm32(R & 31);
        RA[i] = R; CA[i] = C; voffA[i] = (unsigned)(R * K + C) * 2u; voffB[i] = (unsigned)(((R >> 5) * 64 + perm32(R & 31)) * K + C) * 2u; (void)Rb; }
    const size_t kstep = (size_t)(BK * 2);
    const size_t hstep = (size_t)HALF * K * 2;
    const size_t tstep = 2 * hstep;
    const size_t hB = (size_t)32 * K * 2;
    const unsigned ldsw = (unsigned)wid * 1024u;
    const int aoff = lds_byte(wr * 64 + fr, fq * 8), boff = lds_byte(wc * 32 + fr, fq * 8);
#define PG8_SA(b, h) (((b) * 2 + (h)) * HTB)
#define PG8_SB(b, h) ((4 + (b) * 2 + (h)) * HTB)
#define PG8_STAGE_B(bufoff, gbase) do { _Pragma("unroll") for (int _i = 0; _i < 2; ++_i) \
        __builtin_amdgcn_global_load_lds((const unsigned*)((const char*)(gbase) + voffB[_i]), (LAS unsigned*)(lds + (bufoff) + ldsw + _i * 8192), 16, 0, 0); } while (0)
#define PG8_STAGE_A(bufoff, h, NX, kb) do { _Pragma("unroll") for (int _i = 0; _i < 2; ++_i) { const char* _p; \
        if constexpr (Sched::GATHER) _p = Ab + (kb) + ((NX) ? na[h][_i] : ca[h][_i]); else _p = ((NX) ? nA : cA) + (size_t)(h) * hstep + (kb) + voffA[_i]; \
        __builtin_amdgcn_global_load_lds((const unsigned*)_p, (LAS unsigned*)(lds + (bufoff) + ldsw + _i * 8192), 16, 0, 0); } } while (0)
#define PG8_LDA(dst, b, h) do { _Pragma("unroll") for (int m = 0; m < 4; ++m) dst[m] = cat8(*(const LAS bf16x8*)(lds + PG8_SA(b, h) + aoff + m * 2048), *(const LAS bf16x8*)(lds + PG8_SA(b, h) + aoff + m * 2048 + 1024)); } while (0)
#define PG8_LDB(dst, b, h) do { _Pragma("unroll") for (int n = 0; n < 2; ++n) dst[n] = cat8(*(const LAS bf16x8*)(lds + PG8_SB(b, h) + boff + n * 2048), *(const LAS bf16x8*)(lds + PG8_SB(b, h) + boff + n * 2048 + 1024)); } while (0)
#define PG8_MMA(ai, bj, At, Bt) do { __builtin_amdgcn_s_setprio(1); _Pragma("unroll") for (int m = 0; m < 4; ++m) _Pragma("unroll") for (int n = 0; n < 2; ++n) { \
        if constexpr (FP8) asm volatile("v_mfma_scale_f32_16x16x128_f8f6f4 %0, %1, %2, %0, %3, %3 op_sel_hi:[0,0,0]" : "+v"(acc[ai][bj][m][n]) : "v"(Bt[n]), "v"(At[m]), "v"(one_scale)); \
        else { acc[ai][bj][m][n] = __builtin_amdgcn_mfma_f32_16x16x32_bf16(lo8(Bt[n]), lo8(At[m]), acc[ai][bj][m][n], 0, 0, 0); \
               acc[ai][bj][m][n] = __builtin_amdgcn_mfma_f32_16x16x32_bf16(hi8(Bt[n]), hi8(At[m]), acc[ai][bj][m][n], 0, 0, 0); } } \
        __builtin_amdgcn_s_setprio(0); } while (0)
#define PG8_WAIT_V(n) asm volatile("s_waitcnt vmcnt(" #n ")" ::: "memory")
#define PG8_WAIT_L(n) asm volatile("s_waitcnt lgkmcnt(" #n ")" ::: "memory")
#define PG8_BAR __builtin_amdgcn_s_barrier()
#define PG8_SCHED __builtin_amdgcn_sched_barrier(0)
    Unit cur, nxt; int ui = 0;
    if (!S.next(0, cur)) return;
    Acc acc;
#pragma unroll
    for (int a = 0; a < 2; ++a)
#pragma unroll
        for (int b = 0; b < 2; ++b)
#pragma unroll
            for (int m = 0; m < 4; ++m)
#pragma unroll
                for (int n = 0; n < 2; ++n) acc[a][b][m][n] = (f32x4){0.f, 0.f, 0.f, 0.f};
    v8i At[4], B0[2], B1[2];
    int one_scale = 127; asm volatile("" : "+v"(one_scale));
#define PG8_MFMA_PAD() do { if constexpr (FP8) asm volatile("s_nop 15\n\ts_nop 7" ::: "memory"); } while (0)
    unsigned ca[2][2], na[2][2];
    const char* Ab = (const char*)g.A;
    const char* cA = Ab + (size_t)cur.pm * tstep; const char* nA = cA;
    if constexpr (Sched::GATHER) { a_offsets(S, cur, RA, CA, K, ca);
#pragma unroll
        for (int h = 0; h < 2; ++h)
#pragma unroll
            for (int i = 0; i < 2; ++i) na[h][i] = ca[h][i]; }
    const char* cB = (const char*)g.Bt + (size_t)S.btile(cur) * tstep;
    PG8_STAGE_B(PG8_SB(0, 0), cB); PG8_STAGE_B(PG8_SB(0, 1), cB + hB); PG8_STAGE_A(PG8_SA(0, 0), 0, false, (size_t)0); PG8_STAGE_A(PG8_SA(0, 1), 1, false, (size_t)0);
    if (wr == 1) PG8_BAR;
    PG8_WAIT_V(2); PG8_BAR;
    PG8_STAGE_B(PG8_SB(1, 0), cB + kstep); PG8_STAGE_A(PG8_SA(1, 0), 0, false, kstep); PG8_STAGE_B(PG8_SB(1, 1), cB + hB + kstep);
    PG8_WAIT_V(6); PG8_BAR;
    for (;;) {
        const bool has_next = S.next(ui + 1, nxt);
        if constexpr (Sched::GATHER) { if (has_next) a_offsets(S, nxt, RA, CA, K, na); }
        else nA = has_next ? Ab + (size_t)nxt.pm * tstep : cA;
        const char* nB = has_next ? (const char*)g.Bt + (size_t)S.btile(nxt) * tstep : cB;
        for (int t = 0; t < nt; t += 2) {
            const bool last = (t == nt - 2);
            if constexpr (Epi::MIDHOOK) { if (t == Epi::T1 || t == Epi::T2) E.mid(acc, cur, t, wr, wc, fr, fq); }
            const size_t a1k = (size_t)(t + 1) * kstep;
            const size_t a2k = last ? (size_t)0 : (size_t)(t + 2) * kstep, a3k = a2k + kstep;
            const char* b2 = last ? nB : cB + (size_t)(t + 2) * kstep; const char* b3 = b2 + kstep;
            PG8_LDB(B0, 0, 0); PG8_LDB(B1, 0, 1); PG8_SCHED; PG8_LDA(At, 0, 0); PG8_STAGE_A(PG8_SA(1, 1), 1, false, a1k);
            PG8_WAIT_V(8); PG8_WAIT_L(0); PG8_BAR; PG8_MMA(0, 0, At, B0); PG8_MMA(0, 1, At, B1); PG8_BAR; PG8_SCHED;
            PG8_LDA(At, 0, 1); PG8_STAGE_B(PG8_SB(0, 0), b2); PG8_STAGE_B(PG8_SB(0, 1), b2 + hB); PG8_STAGE_A(PG8_SA(0, 0), 0, last, a2k);
            PG8_WAIT_V(8); PG8_WAIT_L(0); PG8_BAR; PG8_MMA(1, 0, At, B0); PG8_MMA(1, 1, At, B1); PG8_BAR; PG8_SCHED;
            PG8_LDB(B0, 1, 0); PG8_LDB(B1, 1, 1); PG8_SCHED; PG8_LDA(At, 1, 0); PG8_STAGE_A(PG8_SA(0, 1), 1, last, a2k);
            PG8_WAIT_V(8); PG8_WAIT_L(0); PG8_BAR; PG8_MMA(0, 0, At, B0); PG8_MMA(0, 1, At, B1); PG8_BAR; PG8_SCHED;
            PG8_LDA(At, 1, 1); PG8_STAGE_B(PG8_SB(1, 0), b3); PG8_STAGE_B(PG8_SB(1, 1), b3 + hB); PG8_STAGE_A(PG8_SA(1, 0), 0, last, a3k);
            PG8_WAIT_V(8); PG8_WAIT_L(0); PG8_BAR; PG8_MMA(1, 0, At, B0); PG8_MMA(1, 1, At, B1); PG8_BAR; PG8_SCHED;
        }
        if (wr == 0) PG8_BAR;
        PG8_MFMA_PAD();
        E(acc, cur, wr, wc, fr, fq);
        if (!has_next) break;
#pragma unroll
        for (int a = 0; a < 2; ++a)
#pragma unroll
            for (int b = 0; b < 2; ++b)
#pragma unroll
                for (int m = 0; m < 4; ++m)
#pragma unroll
                    for (int n = 0; n < 2; ++n) acc[a][b][m][n] = (f32x4){0.f, 0.f, 0.f, 0.f};
        PG8_MFMA_PAD();
        cur = nxt; cB = nB; cA = nA; ++ui;
        if constexpr (Sched::GATHER) {
#pragma unroll
            for (int h = 0; h < 2; ++h)
#pragma unroll
                for (int i = 0; i < 2; ++i) ca[h][i] = na[h][i]; }
        if (wr == 1) PG8_BAR;
    }
    PG8_WAIT_V(0);
    PG8_BAR;
#undef PG8_SA
#undef PG8_SB
#undef PG8_STAGE_A
#undef PG8_STAGE_B
#undef PG8_LDA
#undef PG8_LDB
#undef PG8_MMA
#undef PG8_WAIT_V
#undef PG8_WAIT_L
#undef PG8_BAR
#undef PG8_SCHED
#undef PG8_MFMA_PAD
}

__device__ __forceinline__ u32x4 pack8(const f32x4& v0, const f32x4& v1) { u32x4 w; w.x = cvt_pk_bf16(v0[0], v0[1]); w.y = cvt_pk_bf16(v0[2], v0[3]); w.z = cvt_pk_bf16(v1[0], v1[1]); w.w = cvt_pk_bf16(v1[2], v1[3]); return w; }

constexpr int EPI_OFF = LDSCTL_OFF + 2048, EPI_WAVE = 16 * 144;
static_assert(EPI_OFF + NWAVES * EPI_WAVE <= LDS_BYTES, "epilogue staging fits");
__device__ __forceinline__ LAS unsigned char* epi_stage(int wv) { extern __shared__ __attribute__((aligned(16))) unsigned char lds_raw[]; return (LAS unsigned char*)lds_raw + EPI_OFF + wv * EPI_WAVE; }
__device__ __forceinline__ void store16x128(bf16* blk, size_t ldc, const u32x4& a, const u32x4& b, int lane, int wv) {
    LAS unsigned char* st = epi_stage(wv);
    const int fq = lane >> 4, fr = lane & 15, r = lane >> 3, p = lane & 7;
    *(LAS u32x4*)(st + fr * 144 + 16 * fq) = a; *(LAS u32x4*)(st + fr * 144 + 64 + 16 * fq) = b;
    const u32x4 s1 = *(const LAS u32x4*)(st + r * 144 + 16 * p), s2 = *(const LAS u32x4*)(st + (r + 8) * 144 + 16 * p);
    bf16* q = blk + (size_t)r * ldc + p * 8;
    *(u32x4*)q = s1; *(u32x4*)(q + 8 * ldc) = s2;
}
__device__ __forceinline__ void store16x64(unsigned char* blk, size_t ldc, const u32x2& a, const u32x2& b, int lane, int wv) {
    LAS unsigned char* st = epi_stage(wv);
    const int fq = lane >> 4, fr = lane & 15, r = lane >> 2, p = lane & 3;
    *(LAS u32x2*)(st + fr * 80 + 8 * fq) = a; *(LAS u32x2*)(st + fr * 80 + 32 + 8 * fq) = b;
    const u32x4 s = *(const LAS u32x4*)(st + r * 80 + 16 * p);
    *(u32x4*)(blk + (size_t)r * ldc + p * 16) = s;
}
struct EpiPlain {
    static constexpr bool MIDHOOK = false; static constexpr int T1 = -1, T2 = -1;
    bf16* O; int ldc; float scale;
    __device__ __forceinline__ void operator()(const Acc& acc, const Unit& u, int wr, int wc, int fr, int fq) const {
        bf16* tile = O + (size_t)(u.pm * BM + wr * 64) * ldc + u.pn * BM + wc * 64;
        const int lane = fq * 16 + fr;
#pragma unroll
        for (int ai = 0; ai < 2; ++ai)
#pragma unroll
            for (int m = 0; m < 4; ++m)
                store16x128(tile + (size_t)(ai * HALF + m * 16) * ldc, (size_t)ldc, pack8(acc[ai][0][m][0] * scale, acc[ai][0][m][1] * scale), pack8(acc[ai][1][m][0] * scale, acc[ai][1][m][1] * scale), lane, wr * 4 + wc);
    }
};
struct EpiPlain8 {
    static constexpr bool MIDHOOK = false; static constexpr int T1 = -1, T2 = -1;
    unsigned char* O; int ldc; float scale;
    __device__ __forceinline__ void operator()(const Acc& acc, const Unit& u, int wr, int wc, int fr, int fq) const {
        unsigned char* tile = O + (size_t)(u.pm * BM + wr * 64) * ldc + u.pn * BM + wc * 64;
        const int lane = fq * 16 + fr;
#pragma unroll
        for (int ai = 0; ai < 2; ++ai)
#pragma unroll
            for (int m = 0; m < 4; ++m) { u32x2 w[2];
#pragma unroll
                for (int bj = 0; bj < 2; ++bj) { const f32x4 v0 = acc[ai][bj][m][0] * scale, v1 = acc[ai][bj][m][1] * scale; w[bj].x = pack4_fp8(v0[0], v0[1], v0[2], v0[3]); w[bj].y = pack4_fp8(v1[0], v1[1], v1[2], v1[3]); }
                store16x64(tile + (size_t)(ai * HALF + m * 16) * ldc, (size_t)ldc, w[0], w[1], lane, wr * 4 + wc); }
    }
};
__device__ __forceinline__ void gate_tile(const Acc& acc, unsigned char* G, const float* bgate, float scale, int row_strip  , int gcol  , int fr, int fq, int wv) {
    unsigned char* tile = G + (size_t)row_strip * GP + gcol;
    const int lane = fq * 16 + fr;
    f32x4 bv[2][2]; const float s2 = -LOG2E * scale;
#pragma unroll
    for (int bj = 0; bj < 2; ++bj)
#pragma unroll
        for (int n = 0; n < 2; ++n) { const f32x4 b_ = *(const f32x4*)(bgate + gcol + bj * 32 + 8 * fq + 4 * n);
#pragma unroll
            for (int j = 0; j < 4; ++j) bv[bj][n][j] = __builtin_amdgcn_exp2f(b_[j] * -LOG2E); }
#pragma unroll
    for (int ai = 0; ai < 2; ++ai)
#pragma unroll
        for (int m = 0; m < 4; ++m) { u32x2 w[2];
#pragma unroll
            for (int bj = 0; bj < 2; ++bj) { unsigned q[8];
#pragma unroll
                for (int n = 0; n < 2; ++n)
#pragma unroll
                    for (int j = 0; j < 4; j += 2) {
                        const f32x2 a2 = {acc[ai][bj][m][n][j], acc[ai][bj][m][n][j + 1]}, b2 = {bv[bj][n][j], bv[bj][n][j + 1]};
                        const f32x2 t2 = a2 * s2;
                        f32x2 d2 = {__builtin_amdgcn_exp2f(t2[0]), __builtin_amdgcn_exp2f(t2[1])}; d2 = d2 * b2 + 1.f;
                        f32x2 g2 = {__builtin_amdgcn_rcpf(d2[0]), __builtin_amdgcn_rcpf(d2[1])}; g2 = g2 * 255.f + 0.5f;
                        const unsigned q0 = (unsigned)g2[0], q1 = (unsigned)g2[1]; q[4 * n + j] = q0 > 1u ? q0 : 1u; q[4 * n + j + 1] = q1 > 1u ? q1 : 1u; }
                w[bj].x = (q[0] | (q[1] << 8)) | ((q[2] | (q[3] << 8)) << 16); w[bj].y = (q[4] | (q[5] << 8)) | ((q[6] | (q[7] << 8)) << 16); }
            store16x64(tile + (size_t)(ai * HALF + m * 16) * GP, (size_t)GP, w[0], w[1], lane, wv); }
}
struct EpiInProj {
    static constexpr bool MIDHOOK = false; static constexpr int T1 = -1, T2 = -1;
    bf16* Z; unsigned char* G; const float* bgate;
    __device__ __forceinline__ void operator()(const Acc& acc, const Unit& u, int wr, int wc, int fr, int fq) const {
        if (u.pn < 20) {
            bf16* tile = Z + (size_t)(u.pm * BM + wr * 64) * ZP + u.pn * BM + wc * 64;
            const int lane = fq * 16 + fr;
#pragma unroll
            for (int ai = 0; ai < 2; ++ai)
#pragma unroll
                for (int m = 0; m < 4; ++m)
                    store16x128(tile + (size_t)(ai * HALF + m * 16) * ZP, (size_t)ZP, pack8(acc[ai][0][m][0], acc[ai][0][m][1]), pack8(acc[ai][1][m][0], acc[ai][1][m][1]), lane, wr * 4 + wc);
        } else gate_tile(acc, G, bgate, 1.f, u.pm * BM + wr * 64, (u.pn - 20) * BM + wc * 64, fr, fq, wr * 4 + wc);
    }
};
struct EpiGates {
    static constexpr bool MIDHOOK = false; static constexpr int T1 = -1, T2 = -1;
    unsigned char* G; const float* bgate; float scale;
    __device__ __forceinline__ void operator()(const Acc& acc, const Unit& u, int wr, int wc, int fr, int fq) const { gate_tile(acc, G, bgate, scale, u.pm * BM + wr * 64, u.pn * BM + wc * 64, fr, fq, wr * 4 + wc); }
};
struct EpiBranch {
    static constexpr bool MIDHOOK = true; static constexpr int T1 = 12, T2 = 20;
    const unsigned char* G; bf16* MG;
    __device__ __forceinline__ void mid(Acc& acc, const Unit& u, int t, int wr, int wc, int fr, int fq) const {
        const int row0 = u.pm * BM + wr * 64 + fr, col0 = u.pn * BM + wc * 64 + 8 * fq, gsel = (t == T1) ? 0 : DM;
        const unsigned char* gbase = G + gsel;
        u32x2 ga[2][4][2], gb[2][4][2];
#pragma unroll
        for (int ai = 0; ai < 2; ++ai)
#pragma unroll
            for (int m = 0; m < 4; ++m)
#pragma unroll
                for (int bj = 0; bj < 2; ++bj) { const unsigned off = (unsigned)(row0 + ai * HALF + m * 16) * (unsigned)GP + (unsigned)(col0 + bj * 32);
                    ga[ai][m][bj] = *(const u32x2*)(gbase + off); gb[ai][m][bj] = *(const u32x2*)(gbase + off + DM); }
#pragma unroll
        for (int ai = 0; ai < 2; ++ai)
#pragma unroll
            for (int m = 0; m < 4; ++m)
#pragma unroll
                for (int bj = 0; bj < 2; ++bj)
#pragma unroll
                    for (int n = 0; n < 2; ++n)
#pragma unroll
                        for (int j = 0; j < 4; ++j) acc[ai][bj][m][n][j] *= ub(ga[ai][m][bj][n], j) * __builtin_amdgcn_rcpf(ub(gb[ai][m][bj][n], j));
    }
    __device__ __forceinline__ void operator()(const Acc& acc, const Unit& u, int wr, int wc, int fr, int fq) const {
        const int row0 = u.pm * BM + wr * 64 + fr, col0 = u.pn * BM + wc * 64 + 8 * fq;
        bf16* tile = MG + (size_t)(u.pm * BM + wr * 64) * DM + u.pn * BM + wc * 64;
        const int lane = fq * 16 + fr;
        u32x2 g2a[2][4][2];
#pragma unroll
        for (int ai = 0; ai < 2; ++ai)
#pragma unroll
            for (int m = 0; m < 4; ++m)
#pragma unroll
                for (int bj = 0; bj < 2; ++bj) g2a[ai][m][bj] = *(const u32x2*)(G + (size_t)(row0 + ai * HALF + m * 16) * GP + 2 * DM + col0 + bj * 32);
#pragma unroll
        for (int ai = 0; ai < 2; ++ai)
#pragma unroll
            for (int m = 0; m < 4; ++m) { u32x4 pk[2];
#pragma unroll
                for (int bj = 0; bj < 2; ++bj) { const u32x2 g2 = g2a[ai][m][bj];
                    f32x4 v0 = acc[ai][bj][m][0], v1 = acc[ai][bj][m][1];
#pragma unroll
                    for (int j = 0; j < 4; ++j) { v0[j] *= ub(g2.x, j) * (1.f / 255.f); v1[j] *= ub(g2.y, j) * (1.f / 255.f); }
                    pk[bj] = pack8(v0, v1); }
                store16x128(tile + (size_t)(ai * HALF + m * 16) * DM, (size_t)DM, pk[0], pk[1], lane, wr * 4 + wc); }
    }
};
struct EpiSwiGLU {
    static constexpr bool MIDHOOK = false; static constexpr int T1 = -1, T2 = -1;
    bf16* U; int ldc;
    __device__ __forceinline__ void operator()(const Acc& acc, const Unit& u, int wr, int wc, int fr, int fq) const {
        const int row0 = u.pm * BM + wr * 64 + fr, col0 = u.pn * HALF + wc * 32 + 8 * fq;
#pragma unroll
        for (int ai = 0; ai < 2; ++ai)
#pragma unroll
            for (int m = 0; m < 4; ++m) { f32x4 v[2];
#pragma unroll
                for (int n = 0; n < 2; ++n)
#pragma unroll
                    for (int j = 0; j < 4; ++j) { const float gt = acc[ai][0][m][n][j], up = acc[ai][1][m][n][j]; v[n][j] = gt * fast_sigmoid(gt) * up; }
                *(u32x4*)(U + (size_t)(row0 + ai * HALF + m * 16) * ldc + col0) = pack8(v[0], v[1]); }
    }
};
struct EpiSwiGLU8 {
    static constexpr bool MIDHOOK = false; static constexpr int T1 = -1, T2 = -1;
    unsigned char* U; int ldc; float ginv, uinv;
    __device__ __forceinline__ void operator()(const Acc& acc, const Unit& u, int wr, int wc, int fr, int fq) const {
        const int lane = fq * 16 + fr; LAS unsigned char* st = epi_stage(wr * 4 + wc);
        const float c2 = -LOG2E * ginv, kinv = 1.f / (ginv * uinv);
        unsigned char* strip = U + (size_t)(u.pm * BM + wr * 64 + (lane >> 1)) * ldc + u.pn * HALF + wc * 32 + 16 * (lane & 1);
#pragma unroll
        for (int ai = 0; ai < 2; ++ai)
#pragma unroll
            for (int mp = 0; mp < 2; ++mp) {
#pragma unroll
                for (int mm = 0; mm < 2; ++mm) { const int m = 2 * mp + mm; float v[8];
#pragma unroll
                    for (int n = 0; n < 2; ++n)
#pragma unroll
                        for (int j = 0; j < 4; j += 2) {
                            const f32x2 ag = {acc[ai][0][m][n][j], acc[ai][0][m][n][j + 1]}, au = {acc[ai][1][m][n][j], acc[ai][1][m][n][j + 1]};
                            const f32x2 t2 = ag * c2; f32x2 e2 = {__builtin_amdgcn_exp2f(t2[0]), __builtin_amdgcn_exp2f(t2[1])}; e2 = e2 * kinv + kinv;
                            const f32x2 r2 = {__builtin_amdgcn_rcpf(e2[0]), __builtin_amdgcn_rcpf(e2[1])}; const f32x2 v2 = (ag * au) * r2; v[4 * n + j] = v2[0]; v[4 * n + j + 1] = v2[1]; }
                    u32x2 w; w.x = pack4_fp8(v[0], v[1], v[2], v[3]); w.y = pack4_fp8(v[4], v[5], v[6], v[7]);
                    *(LAS u32x2*)(st + (fr + 16 * mm) * 48 + 8 * fq) = w; }
                const u32x4 sv = *(const LAS u32x4*)(st + (lane >> 1) * 48 + 16 * (lane & 1));
                *(u32x4*)(strip + (size_t)(ai * HALF + mp * 32) * ldc) = sv; }
    }
};
}

namespace att {
constexpr int AT_NSLOT = 4, AT_K = 0, AT_V = AT_NSLOT * 8192, AT_CS = AT_V + AT_NSLOT * 16384, AT_SCR = AT_CS + 8192;
struct Args {
    const bf16* Z; bf16* O; const float* LF;
    const float* sinks;
    const float* subln;
    float lam, lam_init;
};
__device__ __forceinline__ float swapmax(float v) { auto rr = __builtin_amdgcn_permlane32_swap(__float_as_uint(v), __float_as_uint(v), false, false); return fmaxf(__uint_as_float(rr[0]), __uint_as_float(rr[1])); }
__device__ __forceinline__ float swapsum(float v) { auto rr = __builtin_amdgcn_permlane32_swap(__float_as_uint(v), __float_as_uint(v), false, false); return __uint_as_float(rr[0]) + __uint_as_float(rr[1]); }
__device__ __forceinline__ void glds16(const void* gsrc, unsigned lds_dst) { unsigned keep; const unsigned dst = (unsigned)__builtin_amdgcn_readfirstlane((int)lds_dst);
    asm volatile("s_mov_b32 %0, m0\n\ts_mov_b32 m0, %2\n\ts_nop 0\n\tglobal_load_lds_dwordx4 %1, off\n\ts_mov_b32 m0, %0" : "=&s"(keep) : "v"(gsrc), "s"(dst) : "memory"); }
typedef short v4i16_t __attribute__((ext_vector_type(4)));
__device__ __forceinline__ s16x4 vtr(const LAS unsigned char* p) { return __builtin_bit_cast(s16x4, __builtin_amdgcn_ds_read_tr16_b64_v4i16((LAS v4i16_t*)p)); }

template <int MODE, int NDB>
__device__ __forceinline__ void attn_pass(int tid, f32x16 (&o)[NDB], const bf16* Zb  , LAS unsigned char* lds, int q0, int qcol, int kcol, int vcol, float slope2, float sink2, const float* lfp = nullptr  ) {
    const int lane = tid & 63, r32 = lane & 31, hi = lane >> 5, wid = __builtin_amdgcn_readfirstlane(tid >> 6);
    const int qw = q0 + 32 * wid, tq = qw + r32;
    const int jt_lo = (MODE == 0) ? ((q0 >= 127 ? q0 - 127 : 0) >> 6) : 0, jt_hi = (q0 + 255) >> 6;
    const bf16* kp = Zb + (size_t)lane * ZP + kcol + wid * 8;
    const bf16* vp = Zb + (size_t)(16 * (wid & 3) + (lane >> 2)) * ZP + vcol + (wid >> 2) * 32 + (lane & 3) * 8;
    const unsigned kst = AT_K + wid * 1024, vst = AT_V + wid * 1024;
    const unsigned ldsb = (unsigned)(uintptr_t)lds;
#define ATT_DMA(jj, slot) do { const size_t ro_ = (size_t)((jj) * 64) * ZP; \
        glds16(kp + ro_, ldsb + kst + (slot) * 8192); glds16(vp + ro_, ldsb + vst + (slot) * 16384); \
        if (NDB == 4) glds16(vp + ro_ + 64, ldsb + vst + (slot) * 16384 + 8192); } while (0)
#define ATT_WAIT_BAR(n) do { asm volatile("s_waitcnt vmcnt(" #n ")" ::: "memory"); __builtin_amdgcn_s_waitcnt(0xC07F); __builtin_amdgcn_s_barrier(); asm volatile("" ::: "memory"); } while (0)
    bf16x8 qr[4];
#pragma unroll
    for (int d0 = 0; d0 < 4; ++d0) qr[d0] = *(const bf16x8*)(Zb + (size_t)tq * ZP + qcol + d0 * 16 + hi * 8);
#pragma unroll
    for (int db = 0; db < NDB; ++db) o[db] = f32x16{};
    constexpr float THR = 8.f;
    float mref = 0.f, lrun = 0.f;
    const unsigned kfb = AT_K + hi * 1024 + r32 * 16;
    const unsigned vfb = AT_V + ((lane >> 4) & 1) * 32 + (lane & 3) * 8 + (4 * hi + ((lane & 15) >> 2)) * 64;
#define ATT_ACTIVE(jj) ((64 * (jj) <= qw + 31) && (MODE != 0 || (64 * (jj) + 63 >= qw - 127)))
#define ATT_CSLOAD(P0, P1, jj) do { if (MODE == 2) { const LAS float* cs_ = (const LAS float*)(lds + AT_CS) + 64 * (jj) + 4 * hi; \
            _Pragma("unroll") for (int g4 = 0; g4 < 4; ++g4) { const f32x4 c0 = *(const LAS f32x4*)(cs_ + 8 * g4), c1 = *(const LAS f32x4*)(cs_ + 32 + 8 * g4); \
                _Pragma("unroll") for (int e_ = 0; e_ < 4; ++e_) { P0[4 * g4 + e_] = c0[e_]; P1[4 * g4 + e_] = c1[e_]; } } } } while (0)
#define ATT_CINIT(P0, P1, jj) do { const float nm_ = -mref; \
        if (MODE == 2) { _Pragma("unroll") for (int r = 0; r < 16; ++r) { P0[r] = nm_ - P0[r]; P1[r] = nm_ - P1[r]; } \
        } else { float bv_ = fmaf(slope2, (float)(64 * (jj) + 4 * hi - tq), nm_); const float s5_ = 5.f * slope2;        \
            _Pragma("unroll") for (int r = 0; r < 32; ++r) { if (r) bv_ += ((r & 3) ? slope2 : s5_); if (r < 16) P0[r] = bv_; else P1[r - 16] = bv_; } } } while (0)
#define ATT_QKM(P0, P1) do { _Pragma("unroll") for (int d0 = 0; d0 < 4; ++d0) { \
            P0 = __builtin_amdgcn_mfma_f32_32x32x16_bf16(kf[2 * d0], qr[d0], P0, 0, 0, 0); P1 = __builtin_amdgcn_mfma_f32_32x32x16_bf16(kf[2 * d0 + 1], qr[d0], P1, 0, 0, 0); } } while (0)
#define ATT_EXPS(SC0, SC1) do { _Pragma("unroll") for (int r = 0; r < 16; ++r) { SC0[r] = __builtin_amdgcn_exp2f(SC0[r]); SC1[r] = __builtin_amdgcn_exp2f(SC1[r]); } } while (0)
#define ATT_KLOAD(slot) do { const LAS unsigned char* kb_ = lds + kfb + (slot) * 8192; \
        _Pragma("unroll") for (int d0 = 0; d0 < 4; ++d0) { kf[2 * d0] = *(const LAS bf16x8*)(kb_ + d0 * 2048); kf[2 * d0 + 1] = *(const LAS bf16x8*)(kb_ + d0 * 2048 + 512); } } while (0)
#define ATT_VLOAD(slot, dbp) do { const LAS unsigned char* vb_ = lds + vfb + (slot) * 16384 + (dbp) * 4096; \
        _Pragma("unroll") for (int i_ = 0; i_ < 8; ++i_) { const s16x4 lo = vtr(vb_ + (i_ >> 2) * 4096 + (i_ & 3) * 1024), hh = vtr(vb_ + (i_ >> 2) * 4096 + (i_ & 3) * 1024 + 512); \
            kf[i_] = (bf16x8){lo[0], lo[1], lo[2], lo[3], hh[0], hh[1], hh[2], hh[3]}; } } while (0)
#define ATT_PV(dbp) do { _Pragma("unroll") for (int i_ = 0; i_ < 8; ++i_) o[(dbp) + (i_ >> 2)] = __builtin_amdgcn_mfma_f32_32x32x16_bf16(kf[i_], __builtin_bit_cast(bf16x8, pw[i_ & 3]), o[(dbp) + (i_ >> 2)], 0, 0, 0); } while (0)
    bf16x8 kf[8];
    ATT_DMA(jt_lo, 0); ATT_DMA(jt_lo + 1, 1); ATT_DMA(jt_lo + 2, 2);
    if (MODE == 2) {
        const int n = q0 + 256; float v[4];
#pragma unroll
        for (int c = 0; c < 4; ++c) { const int s_ = 4 * tid + c; v[c] = (s_ < n) ? lfp[(size_t)s_ * 16] * LOG2E : 0.f; }
        v[1] += v[0]; v[2] += v[1]; v[3] += v[2];
        float wtot; const float inc = wave_incl_scan(v[3], lane, wtot);
        LAS float* scr = (LAS float*)(lds + AT_SCR);
        if (lane == 63) scr[wid] = wtot;
        __syncthreads();
        float woff = 0.f;
#pragma unroll
        for (int w = 0; w < 8; ++w) woff += (w < wid) ? scr[w] : 0.f;
        const float ex = inc - v[3] + woff;
        LAS float* cs = (LAS float*)(lds + AT_CS);
        if (4 * tid < n) *(LAS f32x4*)(cs + 4 * tid) = (f32x4){v[0] + ex, v[1] + ex, v[2] + ex, v[3] + ex};
    }
#pragma unroll
    for (int d0 = 0; d0 < 4; ++d0) asm volatile("" : "+v"(qr[d0]));
    if (NDB == 4) ATT_WAIT_BAR(3); else ATT_WAIT_BAR(2);
    f32x16 pa0 = f32x16{}, pa1 = f32x16{}, pb0 = f32x16{}, pb1 = f32x16{};
    if (ATT_ACTIVE(jt_lo)) { ATT_KLOAD(0); ATT_CSLOAD(pa0, pa1, jt_lo); ATT_CINIT(pa0, pa1, jt_lo); ATT_QKM(pa0, pa1); }
    const int rl = r32 - 4 * hi;
#define ATT_ITER(SC0, SC1, SN0, SN1, J) do { const int j = (J); \
        const int buf = (j - jt_lo) & 3; \
        const bool more1 = (j < jt_hi), more3 = (j + 3 <= jt_hi); \
        const bool act = ATT_ACTIVE(j), actn = more1 && ATT_ACTIVE(j + 1); \
        if (actn) ATT_KLOAD((buf + 1) & 3); \
        __builtin_amdgcn_sched_barrier(0); \
        if (act) { \
            const int D0 = qw - 64 * j; \
            if (MODE == 0) { \
                const int kvb = 64 * j + 4 * hi; \
_Pragma("unroll") \
                for (int r = 0; r < 16; ++r) { const int d0 = tq - (kvb + (r & 3) + 8 * (r >> 2)), d1 = d0 - 32; \
                    SC0[r] = ((unsigned)d0 < 128u) ? SC0[r] : -INFINITY; SC1[r] = ((unsigned)d1 < 128u) ? SC1[r] : -INFINITY; } \
            } else if (D0 <= 32) { \
                int rlv = rl; asm volatile("" : "+v"(rlv)); \
                const int t0 = (D0 == 0) ? rlv : 127, t1 = (D0 == 0) ? -1 : rlv; \
_Pragma("unroll") \
                for (int r = 0; r < 16; ++r) { const int cr = (r & 3) + 8 * (r >> 2); SC0[r] = (cr <= t0) ? SC0[r] : -INFINITY; SC1[r] = (cr <= t1) ? SC1[r] : -INFINITY; } \
            } \
            float mx = fmaxf(fmaxf(SC0[0], SC1[0]), SC0[1]); \
_Pragma("unroll") \
            for (int r = 1; r < 16; ++r) mx = fmaxf(fmaxf(mx, SC1[r]), (r < 15) ? SC0[r + 1] : SC1[r]); \
            mx = swapmax(mx); \
            if (__any(mx > THR)) { \
                const float dl = fmaxf(mx, 0.f), f = __builtin_amdgcn_exp2f(-dl); \
                mref += dl; lrun *= f; \
_Pragma("unroll") \
                for (int r = 0; r < 16; ++r) { SC0[r] -= dl; SC1[r] -= dl; } \
_Pragma("unroll") \
                for (int db = 0; db < NDB; ++db) \
_Pragma("unroll") \
                    for (int r = 0; r < 16; ++r) o[db][r] *= f; \
            } \
        } \
        __builtin_amdgcn_sched_barrier(0); \
        if (more3) ATT_DMA(j + 3, (buf + 3) & 3);         \
        if (actn) { ATT_CSLOAD(SN0, SN1, j + 1); ATT_CINIT(SN0, SN1, j + 1); }         \
        __builtin_amdgcn_sched_barrier(0); \
        if (act || actn) { ATT_QKM(SN0, SN1); ATT_EXPS(SC0, SC1);         \
_Pragma("unroll") \
            for (int g_ = 0; g_ < 8; ++g_) { __builtin_amdgcn_sched_group_barrier(0x008, 1, 0); __builtin_amdgcn_sched_group_barrier(0x400, 4, 0); } \
        } \
        __builtin_amdgcn_sched_barrier(0); \
        if (act) { \
            ATT_VLOAD(buf, 0); \
            float rs = SC0[0]; \
_Pragma("unroll") \
            for (int r = 0; r < 16; ++r) { if (r) rs += SC0[r]; rs += SC1[r]; } \
            lrun += rs; \
            u32x4 pw[4]; \
_Pragma("unroll") \
            for (int w = 0; w < 4; ++w) { pw[0][w] = cvt_pk_bf16(SC0[2 * w], SC0[2 * w + 1]); pw[1][w] = cvt_pk_bf16(SC0[8 + 2 * w], SC0[8 + 2 * w + 1]); \
                                          pw[2][w] = cvt_pk_bf16(SC1[2 * w], SC1[2 * w + 1]); pw[3][w] = cvt_pk_bf16(SC1[8 + 2 * w], SC1[8 + 2 * w + 1]); } \
            ATT_PV(0); \
            if (NDB == 4) { ATT_VLOAD(buf, 2); ATT_PV(2); } \
        } \
        if (more3) { if (NDB == 4) ATT_WAIT_BAR(3); else ATT_WAIT_BAR(2); } else ATT_WAIT_BAR(0); \
    } while (0)
    for (int jo = jt_lo;;) {
        ATT_ITER(pa0, pa1, pb0, pb1, jo); if (++jo > jt_hi) break;
        ATT_ITER(pb0, pb1, pa0, pa1, jo); if (++jo > jt_hi) break;
    }
#undef ATT_ITER
#undef ATT_CSLOAD
#undef ATT_CINIT
#undef ATT_QKM
#undef ATT_EXPS
#undef ATT_DMA
#undef ATT_WAIT_BAR
#undef ATT_KLOAD
#undef ATT_VLOAD
#undef ATT_PV
#undef ATT_ACTIVE
    float ltot = swapsum(lrun);
    if (MODE == 0) ltot += __builtin_amdgcn_exp2f(sink2 - mref);
    const float inv = (ltot > 0.f) ? 1.f / ltot : 0.f;
#pragma unroll
    for (int db = 0; db < NDB; ++db)
#pragma unroll
        for (int r = 0; r < 16; ++r) o[db][r] *= inv;
}
__device__ __forceinline__ u32x4 pair_swap(u32x2 a, u32x2 b) {
    const auto r0 = __builtin_amdgcn_permlane32_swap(a.x, b.x, false, false), r1 = __builtin_amdgcn_permlane32_swap(a.y, b.y, false, false);
    return (u32x4){r0[0], r1[0], r0[1], r1[1]}; }
template <int NDB> __device__ __forceinline__ void store_o(const f32x16 (&o)[NDB], bf16* Orow  , int hi) {
#pragma unroll
    for (int db = 0; db < NDB; ++db)
#pragma unroll
        for (int g2 = 0; g2 < 2; ++g2) { u32x2 a, b;
            a.x = cvt_pk_bf16(o[db][8 * g2], o[db][8 * g2 + 1]); a.y = cvt_pk_bf16(o[db][8 * g2 + 2], o[db][8 * g2 + 3]);
            b.x = cvt_pk_bf16(o[db][8 * g2 + 4], o[db][8 * g2 + 5]); b.y = cvt_pk_bf16(o[db][8 * g2 + 6], o[db][8 * g2 + 7]);
            *(u32x4*)(Orow + 32 * db + 16 * g2 + 8 * hi) = pair_swap(a, b); }
}
constexpr int NUNITS = 256 + 768 + 768;
__device__ __forceinline__ void attn_unit(int tid, const Args& A, LAS unsigned char* lds, int idx) {
    asm volatile("" : "+v"(tid));
    const int lane = tid & 63, r32 = lane & 31, hi = lane >> 5, wid = __builtin_amdgcn_readfirstlane(tid >> 6);
    if (idx < 256) {
        const int qb = 7 - idx / 32, b = (idx % 32) / 4, h = idx % 4, q0 = qb * 256;
        const bf16* Zb = A.Z + (size_t)b * SEQ * ZP;
        const float slope2 = exp2f(-2.f * (float)(h + 1)) * LOG2E;
        f32x16 o1[4];
        attn_pass<1, 4>(tid, o1, Zb, lds, q0, 1280 + h * 128, 1792 + h * 128, 2304 + h * 128, slope2, 0.f);
        bf16* Orow = A.O + ((size_t)b * SEQ + q0 + 32 * wid + r32) * DM + 768 + h * 128;
        store_o<4>(o1, Orow, hi);
        attn_pass<1, 4>(tid, o1, Zb, lds, q0, 1280 + h * 128 + 64, 1792 + h * 128 + 64, 2304 + h * 128, slope2, 0.f);
        asm volatile("s_waitcnt vmcnt(0)" ::: "memory");
        float ss = 0.f;
#pragma unroll
        for (int db = 0; db < 4; ++db)
#pragma unroll
            for (int g2 = 0; g2 < 2; ++g2) { const u32x4 q4 = *(const volatile u32x4*)(Orow + 32 * db + 16 * g2 + 8 * hi);
                const u32x4 pk = pair_swap((u32x2){q4.x, q4.y}, (u32x2){q4.z, q4.w});
#pragma unroll
                for (int e = 0; e < 8; ++e) { const unsigned w = (e < 2) ? pk.x : (e < 4) ? pk.y : (e < 6) ? pk.z : pk.w;
                    const float a = ((e & 1) ? bf_hi(w) : bf_lo(w)) - A.lam * o1[db][8 * g2 + e]; o1[db][8 * g2 + e] = a; ss += a * a; } }
        ss = swapsum(ss);
        const float rn = rsqrtf(ss * (1.f / 128.f) + RMS_EPS) ;
        const float post = 1.f - A.lam_init;
#pragma unroll
        for (int db = 0; db < 4; ++db)
#pragma unroll
            for (int g4 = 0; g4 < 4; ++g4) { const f32x4 gn = *(const f32x4*)(A.subln + 32 * db + 8 * g4 + 4 * hi);
#pragma unroll
                for (int e = 0; e < 4; ++e) o1[db][4 * g4 + e] = (o1[db][4 * g4 + e] * rn) * gn[e] * post; }
        store_o<4>(o1, Orow, hi);
    } else if (idx < 1024) {
        const int j = idx - 256, qb = 7 - j / 96, b = (j % 96) / 12, h = j % 12, q0 = qb * 256;
        const bf16* Zb = A.Z + (size_t)b * SEQ * ZP;
        f32x16 o[2];
        attn_pass<2, 2>(tid, o, Zb, lds, q0, 2816 + h * 64, 3584 + h * 64, 4352 + h * 64, 0.f, 0.f, A.LF + (size_t)b * SEQ * 16 + h);
        store_o<2>(o, A.O + ((size_t)b * SEQ + q0 + 32 * wid + r32) * DM + 1280 + h * 64, hi);
    } else {
        const int j = idx - 1024, qb = 7 - j / 96, b = (j % 96) / 12, h = j % 12, q0 = qb * 256, kvh = h / 3;
        const bf16* Zb = A.Z + (size_t)b * SEQ * ZP;
        const float slope2 = exp2f(-8.f * (float)(h + 1) / 12.f) * LOG2E;
        f32x16 o[2];
        attn_pass<0, 2>(tid, o, Zb, lds, q0, h * 64, 768 + kvh * 64, 1024 + kvh * 64, slope2, A.sinks[h] * LOG2E);
        store_o<2>(o, A.O + ((size_t)b * SEQ + q0 + 32 * wid + r32) * DM + h * 64, hi);
    }
}
}

#define XB_TMO      128
#define XB_XCNT(j)  (256  + 64 * (j))
#define XB_XSUB(j)  (1280 + 64 * (j))
#define XB_XGEN(j)  (2304 + 64 * (j))
#define XB_TOP      3328
#define XB_TOPGEN   3392
#define XCD_BAR_WORDS 3456
#define XB_SPIN_CAP (1u << 18)
__device__ __forceinline__ unsigned xb_ld(unsigned* p)              { return __hip_atomic_load(p, __ATOMIC_RELAXED, __HIP_MEMORY_SCOPE_AGENT); }
__device__ __forceinline__ unsigned xb_add(unsigned* p, unsigned v) { return __hip_atomic_fetch_add(p, v, __ATOMIC_RELAXED, __HIP_MEMORY_SCOPE_AGENT); }
__device__ __forceinline__ unsigned xb_xcc_id() { return (unsigned)__builtin_amdgcn_s_getreg((3 << 11) | 20) & 0xFu; }
#define XB_SPIN(cond, bar) do { unsigned _sp = 0; while (cond) { __builtin_amdgcn_s_sleep(1); \
    if ((++_sp & 255u) == 0u) { if (xb_ld(&(bar)[XB_TMO])) break; if (_sp > XB_SPIN_CAP) { atomicAdd(&(bar)[XB_TMO], 1u); break; } } } } while (0)
struct XcdBarrier { unsigned* bar; unsigned x; volatile LAS unsigned* st; };
__device__ __forceinline__ XcdBarrier xcd_barrier_post(unsigned* bar, volatile LAS unsigned* st, bool leader) {
    XcdBarrier b; b.bar = bar; b.x = xb_xcc_id(); b.st = st;
    if (leader) (void)xb_add(&bar[XB_XCNT(b.x)], 1u);
    return b;
}
__device__ __forceinline__ void xcd_barrier_complete(unsigned* bar, unsigned x, unsigned& nloc, unsigned& nx) {
    const unsigned G = gridDim.x * gridDim.y * gridDim.z;
    unsigned sum, cnt, mine, sp = 0u;
    for (;;) {
        sum = 0u; cnt = 0u; mine = 0u;
#pragma unroll
        for (unsigned j = 0; j < 16; ++j) { const unsigned c = xb_ld(&bar[XB_XCNT(j)]); sum += c; cnt += (c > 0u) ? 1u : 0u; mine = (j == x) ? c : mine; }
        if (sum == G) break;
        __builtin_amdgcn_s_sleep(1);
        if ((++sp & 255u) == 0u) { if (xb_ld(&bar[XB_TMO])) break; if (sp > XB_SPIN_CAP) { atomicAdd(&bar[XB_TMO], 1u); break; } }
    }
    nloc = mine > 0u ? mine : 1u; nx = cnt > 0u ? cnt : 1u;
}
__device__ __forceinline__ void xcd_barrier(const XcdBarrier& b, bool leader  ) {
    asm volatile("s_waitcnt vmcnt(0)" ::: "memory");
    __syncthreads();
    if (leader) {
        unsigned* bar = b.bar; asm volatile("" : "+s"(bar));
        __builtin_amdgcn_s_waitcnt(0);
        unsigned nloc = b.st[0], nx = b.st[1];
        if (nloc == 0u) { xcd_barrier_complete(bar, b.x, nloc, nx); b.st[0] = nloc; b.st[1] = nx; }
        const unsigned old = xb_add(&bar[XB_XSUB(b.x)], 1u);
        const unsigned gen = old / nloc;
        if (old + 1u == (gen + 1u) * nloc) {
            __builtin_amdgcn_fence(__ATOMIC_RELEASE, "agent");
            asm volatile("s_waitcnt vmcnt(0)" ::: "memory");
            const unsigned og = xb_add(&bar[XB_TOP], 1u);
            const unsigned tg = og / nx;
            if (og + 1u == (tg + 1u) * nx) xb_add(&bar[XB_TOPGEN], 1u);
            else XB_SPIN(xb_ld(&bar[XB_TOPGEN]) == tg, bar);
            __builtin_amdgcn_fence(__ATOMIC_ACQUIRE, "agent");
            xb_add(&bar[XB_XGEN(b.x)], 1u);
            asm volatile("s_waitcnt vmcnt(0)" ::: "memory");
        } else {
            XB_SPIN(xb_ld(&bar[XB_XGEN(b.x)]) == gen, bar);
            __builtin_amdgcn_fence(__ATOMIC_ACQUIRE, "agent");
            asm volatile("s_waitcnt vmcnt(0)" ::: "memory");
        }
    }
    __syncthreads();
}

__device__ __forceinline__ void tr_item(const float* W, int ldw, int k0, int nsrc0, int nvalid, bf16* WT, int ldk, int kdst0, int rdst0, float scale, LAS float* scr, int lane) {
    const int kr = lane >> 3, nc = (lane & 7) * 4;
#pragma unroll
    for (int i = 0; i < 8; ++i) { f32x4 v = (f32x4){0.f, 0.f, 0.f, 0.f};
        if (nc < nvalid) v = *(const f32x4*)(W + (size_t)(k0 + 8 * i + kr) * ldw + nsrc0 + nc);
        LAS float* s = scr + (8 * i + kr) * 33 + nc; s[0] = v[0] * scale; s[1] = v[1] * scale; s[2] = v[2] * scale; s[3] = v[3] * scale; }
    asm volatile("s_waitcnt lgkmcnt(0)" ::: "memory");
    const int c = lane & 7;
#pragma unroll
    for (int j = 0; j < 4; ++j) { const int n = (lane >> 3) + 8 * j; const LAS float* s = scr + (8 * c) * 33 + n;
        u32x4 o; o.x = cvt_pk_bf16(s[0 * 33], s[1 * 33]); o.y = cvt_pk_bf16(s[2 * 33], s[3 * 33]); o.z = cvt_pk_bf16(s[4 * 33], s[5 * 33]); o.w = cvt_pk_bf16(s[6 * 33], s[7 * 33]);
        *(u32x4*)(WT + (size_t)(rdst0 + n) * ldk + kdst0 + k0 + 8 * c) = o; }
    asm volatile("s_waitcnt lgkmcnt(0)" ::: "memory");
}

__device__ __forceinline__ void tr_item8(const float* W, int ldw, int k0, int nsrc0, unsigned char* WT, int ldk, int rdst0, float scale, LAS float* scr, int lane) {
    const int kr = lane >> 3, nc = (lane & 7) * 4;
#pragma unroll
    for (int i = 0; i < 8; ++i) { const f32x4 v = *(const f32x4*)(W + (size_t)(k0 + 8 * i + kr) * ldw + nsrc0 + nc);
        LAS float* s = scr + (8 * i + kr) * 33 + nc; s[0] = v[0] * scale; s[1] = v[1] * scale; s[2] = v[2] * scale; s[3] = v[3] * scale; }
    asm volatile("s_waitcnt lgkmcnt(0)" ::: "memory");
    const int c = lane & 3;
#pragma unroll
    for (int j = 0; j < 2; ++j) { const int n = (lane >> 2) + 16 * j; const LAS float* s = scr + (16 * c) * 33 + n;
        u32x4 o; o.x = pack4_fp8(s[0 * 33], s[1 * 33], s[2 * 33], s[3 * 33]); o.y = pack4_fp8(s[4 * 33], s[5 * 33], s[6 * 33], s[7 * 33]);
        o.z = pack4_fp8(s[8 * 33], s[9 * 33], s[10 * 33], s[11 * 33]); o.w = pack4_fp8(s[12 * 33], s[13 * 33], s[14 * 33], s[15 * 33]);
        *(u32x4*)(WT + (size_t)(rdst0 + n) * ldk + k0 + 16 * c) = o; }
    asm volatile("s_waitcnt lgkmcnt(0)" ::: "memory");
}

struct Args { const float* in[25]; float* out; unsigned char* ws; int ph_lo, ph_hi; };
static_assert(sizeof(Args) == 25 * 8 + 8 + 8 + 8, "Args has no padding");

struct TrDesc { const float* src; int ldw; unsigned char* dst; int pitch; float scale; int fp8; };
__device__ __forceinline__ TrDesc tr_desc(const float* W, int ldw, int k0, int nsrc0, void* WT, int ldk, int kdst0, int rdst0, float scale, int fp8) {
    TrDesc d; d.src = W + (size_t)k0 * ldw + nsrc0; d.ldw = ldw; d.scale = scale; d.fp8 = fp8;
    d.pitch = fp8 ? ldk : 2 * ldk; d.dst = (unsigned char*)WT + (size_t)rdst0 * d.pitch + (size_t)(kdst0 + k0) * (fp8 ? 1 : 2); return d;
}
__device__ __forceinline__ void tr_load(const TrDesc& d, f32x4 (&v)[8], int lane) {
    const int kr = lane >> 3, nc = (lane & 7) * 4;
#pragma unroll
    for (int i = 0; i < 8; ++i) v[i] = __builtin_nontemporal_load((const f32x4*)(d.src + (size_t)(8 * kr + i) * d.ldw + nc));
}
__device__ __forceinline__ void tr_process(const TrDesc& d, const f32x4 (&v)[8], LAS float* scr, int lane) {
    LAS unsigned char* sb = (LAS unsigned char*)scr;
    const int kr = lane >> 3, nq = lane & 7; const float sc = d.scale;
    if (d.fp8) {
#pragma unroll
        for (int e = 0; e < 4; ++e) { u32x2 w;
            w.x = pack4_fp8(v[0][e] * sc, v[1][e] * sc, v[2][e] * sc, v[3][e] * sc); w.y = pack4_fp8(v[4][e] * sc, v[5][e] * sc, v[6][e] * sc, v[7][e] * sc);
            *(LAS u32x2*)(sb + (8 * e + nq) * 80 + 8 * kr) = w; }
        const int c = lane & 3;
#pragma unroll
        for (int j = 0; j < 2; ++j) { const int n = (lane >> 2) + 16 * j; const u32x4 o = *(const LAS u32x4*)(sb + (((n & 3) << 3) | (n >> 2)) * 80 + 16 * c);
            __builtin_nontemporal_store(o, (u32x4*)(d.dst + (size_t)n * d.pitch + 16 * c)); }
    } else {
#pragma unroll
        for (int e = 0; e < 4; ++e) { u32x4 w;
            w.x = cvt_pk_bf16(v[0][e] * sc, v[1][e] * sc); w.y = cvt_pk_bf16(v[2][e] * sc, v[3][e] * sc); w.z = cvt_pk_bf16(v[4][e] * sc, v[5][e] * sc); w.w = cvt_pk_bf16(v[6][e] * sc, v[7][e] * sc);
            *(LAS u32x4*)(sb + (8 * e + nq) * 144 + 16 * kr) = w; }
        const int c = lane & 7;
#pragma unroll
        for (int j = 0; j < 4; ++j) { const int n = (lane >> 3) + 8 * j; const u32x4 o = *(const LAS u32x4*)(sb + (((n & 3) << 3) | (n >> 2)) * 144 + 16 * c);
            __builtin_nontemporal_store(o, (u32x4*)(d.dst + (size_t)n * d.pitch + 16 * c)); }
    }
    asm volatile("s_waitcnt lgkmcnt(0)" ::: "memory");
}
__device__ __forceinline__ TrDesc p0_item(const Args& P, int it) {
    bf16* ws_win = (bf16*)(P.ws + WS_WIN); bf16* ws_wbr = (bf16*)(P.ws + WS_WBR); bf16* ws_wout = (bf16*)(P.ws + WS_WOUT);
    bf16* ws_wgu = (bf16*)(P.ws + WS_WGU); bf16* ws_wd = (bf16*)(P.ws + WS_WD); unsigned char* ws_egu = P.ws + WS_EGU; unsigned char* ws_ed = P.ws + WS_ED;
    constexpr int I_QKV = 32 * 160, I_GT = 32 * 192, I_BA = 12 * 64, I_BB = 8 * 64, I_BC = 12 * 64, I_WO = 32 * 64;
    constexpr int I_LAYER = I_QKV + I_GT + I_BA + I_BB + I_BC + I_WO;
    constexpr int I_DG = 32 * 176, I_DD = 88 * 64;
    constexpr int I_EG = 32 * 224, I_ED = 112 * 64;
    int r = it;
    if (r < 2 * I_LAYER) {
        const int l = r / I_LAYER; r -= l * I_LAYER;
        const float* w_in = P.in[2] + (size_t)l * DM * DIN_SRC; bf16* win_t = ws_win + (size_t)l * NIN * DM;
        if (r < I_QKV) { const int kb = r / 160, nb = r % 160, n0 = nb * 32;
            const bool isq = (n0 < 768) || (n0 >= 1280 && n0 < 1792) || (n0 >= 2816 && n0 < 3584);
            return tr_desc(w_in, DIN_SRC, kb * 64, n0, win_t, DM, 0, n0, isq ? QSCALE : 1.f, 0); } r -= I_QKV;
        if (r < I_GT) { const int kb = r / 192, nb = r % 192;
            if ((MK_FP8_GATES >> l) & 1) return tr_desc(w_in, DIN_SRC, kb * 64, 5132 + nb * 32, win_t + (size_t)5120 * DM, DM, 0, nb * 32, F8_SWG, 1);
            return tr_desc(w_in, DIN_SRC, kb * 64, 5132 + nb * 32, win_t, DM, 0, 5120 + nb * 32, 1.f, 0); } r -= I_GT;
        bf16* wbr_t = ws_wbr + (size_t)l * DM * DM;
        if (r < I_BA) { const int kb = r / 64, nb = r % 64; return tr_desc(P.in[11] + (size_t)l * 768 * DM, DM, kb * 64, nb * 32, wbr_t, DM, 0, nb * 32, 1.f, 0); } r -= I_BA;
        if (r < I_BB) { const int kb = r / 64, nb = r % 64; return tr_desc(P.in[12] + (size_t)l * 512 * DM, DM, kb * 64, nb * 32, wbr_t, DM, 768, nb * 32, 1.f, 0); } r -= I_BB;
        if (r < I_BC) { const int kb = r / 64, nb = r % 64; return tr_desc(P.in[13] + (size_t)l * 768 * DM, DM, kb * 64, nb * 32, wbr_t, DM, 1280, nb * 32, 1.f, 0); } r -= I_BC;
        { const int kb = r / 64, nb = r % 64; return tr_desc(P.in[14] + (size_t)l * DM * DM, DM, kb * 64, nb * 32, ws_wout + (size_t)l * DM * DM, DM, 0, nb * 32, 1.f, 0); }
    }
    r -= 2 * I_LAYER;
    if (r < 2 * I_DG) { const int up = r / I_DG; r -= up * I_DG; const int kb = r / 176, nb = r % 176, n0 = nb * 32;
        return tr_desc(up ? P.in[19] : P.in[18], DFF, kb * 64, n0, ws_wgu, DM, 0, (n0 >> 7) * 256 + ((n0 >> 5) & 3) * 64 + up * 32, 1.f, 0); } r -= 2 * I_DG;
    if (r < I_DD) { const int kb = r / 64, nb = r % 64; return tr_desc(P.in[20], DM, kb * 64, nb * 32, ws_wd, DFF, 0, nb * 32, MK_FP8_DDOWN ? F8_SWD : 1.f, MK_FP8_DDOWN); } r -= I_DD;
    { const int e = r / (2 * I_EG + I_ED); r -= e * (2 * I_EG + I_ED);
      if (r < 2 * I_EG) { const int up = r / I_EG; r -= up * I_EG; const int kb = r / 224, nb = r % 224, n0 = nb * 32;
          return tr_desc((up ? P.in[23] : P.in[22]) + (size_t)e * DM * DFE, DFE, kb * 64, n0, ws_egu + (size_t)e * 2 * DFE * DM, DM, 0, (n0 >> 7) * 256 + ((n0 >> 5) & 3) * 64 + up * 32, F8_SWU, 1); } r -= 2 * I_EG;
      { const int kb = r / 64, nb = r % 64; return tr_desc(P.in[24] + (size_t)e * DFE * DM, DM, kb * 64, nb * 32, ws_ed + (size_t)e * DM * DFE, DFE, 0, nb * 32, F8_SWD, 1); } }
}
constexpr int NI_BASE = 2 * (32 * 160 + 32 * 192 + 12 * 64 + 8 * 64 + 12 * 64 + 32 * 64) + 2 * 32 * 176 + 88 * 64;
constexpr int NI_MOE = NEXP * (2 * 32 * 224 + 112 * 64);
constexpr int NI_P0 = 32 * 160 + 32 * 192;
constexpr int CONV_ITEMS = 128;
constexpr int CONV_L0_START = NI_P0, CONV_L0_UNITS = 816, CONV_L1_START = CONV_L0_START + CONV_L0_UNITS * CONV_ITEMS, CONV_L1_UNITS = (NI_BASE + NI_MOE - CONV_L1_START) / CONV_ITEMS;
static_assert((NI_BASE - NI_P0) % CONV_ITEMS == 0 && (NI_BASE + NI_MOE - CONV_L1_START) % CONV_ITEMS == 0 && CONV_L1_START > NI_BASE, "conversion units are whole; layer 0 takes all the small matrices");
__device__ __forceinline__ void tr_walk(const Args& P, LAS unsigned char* lds, int first, int step, int end, int wave, int lane) {
    LAS float* scr = (LAS float*)(lds + RING_OFF + wave * 16384);
    if (first >= end) return;
    TrDesc d0 = p0_item(P, first); f32x4 v[8]; tr_load(d0, v, lane);
    for (int it = first; it < end; it += step) {
        const bool has = (it + step < end);
        TrDesc d1 = d0; f32x4 w[8];
        if (has) { d1 = p0_item(P, it + step); tr_load(d1, w, lane); }
        tr_process(d0, v, scr, lane);
        if (has) { d0 = d1;
#pragma unroll
            for (int i = 0; i < 8; ++i) v[i] = w[i]; }
    }
}
__device__ __forceinline__ void p0_prologue(const Args& P, LAS unsigned char* lds, int gw, int NGW, int wave, int lane) { tr_walk(P, lds, gw, NGW, NI_P0, wave, lane); }
__device__ __forceinline__ void conv_unit(const Args& P, LAS unsigned char* lds, int layer, int u, int wave, int lane) {
    const int base = (layer ? CONV_L1_START : CONV_L0_START) + u * CONV_ITEMS;
    tr_walk(P, lds, base + wave, NWAVES, base + CONV_ITEMS, wave, lane);
}

__device__ __forceinline__ void ld_row_f32(const float* p, int lane, f32x4 (&v)[8]) {
#pragma unroll
    for (int j = 0; j < 8; ++j) v[j] = *(const f32x4*)(p + 4 * lane + 256 * j);
}
__device__ __forceinline__ void ld_row_bf16(const bf16* p, int lane, f32x4 (&v)[8]) {
#pragma unroll
    for (int j = 0; j < 8; ++j) { const u32x2 w = *(const u32x2*)(p + 4 * lane + 256 * j); v[j] = (f32x4){bf_lo(w.x), bf_hi(w.x), bf_lo(w.y), bf_hi(w.y)}; }
}
__device__ __forceinline__ void st_row_f32(float* p, int lane, const f32x4 (&v)[8]) {
#pragma unroll
    for (int j = 0; j < 8; ++j) *(f32x4*)(p + 4 * lane + 256 * j) = v[j];
}
__device__ __forceinline__ void st_row_bf16(bf16* p, int lane, const f32x4 (&v)[8]) {
#pragma unroll
    for (int j = 0; j < 8; ++j) { u32x2 w; w.x = cvt_pk_bf16(v[j][0], v[j][1]); w.y = cvt_pk_bf16(v[j][2], v[j][3]); *(u32x2*)(p + 4 * lane + 256 * j) = w; }
}
__device__ __forceinline__ float row_rstd(const f32x4 (&v)[8]) {
    float s = 0.f;
#pragma unroll
    for (int j = 0; j < 8; ++j) s += (v[j][0] * v[j][0] + v[j][1] * v[j][1]) + (v[j][2] * v[j][2] + v[j][3] * v[j][3]);
    return rsqrtf(wave_sum(s) * (1.f / DM) + RMS_EPS);
}
__device__ __forceinline__ void fc_stage(const float* w_in, LAS unsigned char* lds, int tid) {
    LAS float* wl = (LAS float*)lds;
    for (int k = tid; k < DM; k += 512) { const float* p = w_in + (size_t)k * DIN_SRC + 5120; const f32x4 a = *(const f32x4*)p, b = *(const f32x4*)(p + 4), c = *(const f32x4*)(p + 8);
        wl[0 * DM + k] = a[0]; wl[1 * DM + k] = a[1]; wl[2 * DM + k] = a[2]; wl[3 * DM + k] = a[3]; wl[4 * DM + k] = b[0]; wl[5 * DM + k] = b[1]; wl[6 * DM + k] = b[2]; wl[7 * DM + k] = b[3];
        wl[8 * DM + k] = c[0]; wl[9 * DM + k] = c[1]; wl[10 * DM + k] = c[2]; wl[11 * DM + k] = c[3]; }
    __syncthreads();
}
__device__ __forceinline__ void fc_row(const f32x4 (&v)[8], const LAS unsigned char* lds, const float* bforget, float* LFrow, int lane) {
    const LAS float* wl = (const LAS float*)lds; float mine = 0.f;
#pragma unroll
    for (int c = 0; c < 12; ++c) { float s = 0.f;
#pragma unroll
        for (int j = 0; j < 8; ++j) { const f32x4 w = *(const LAS f32x4*)(wl + c * DM + 4 * lane + 256 * j); s += (v[j][0] * w[0] + v[j][1] * w[1]) + (v[j][2] * w[2] + v[j][3] * w[3]); }
        s = wave_sum(s); mine = (lane == c) ? s : mine; }
    if (lane < 12) { const float x = mine + bforget[lane];
        LFrow[lane] = fminf(x, 0.f) - 0.6931471805599453f * __builtin_amdgcn_logf(1.f + __builtin_amdgcn_exp2f(-LOG2E * fabsf(x))); }
}
__device__ __forceinline__ void st_row_fp8(unsigned char* p, int lane, const f32x4 (&v)[8], float s) {
#pragma unroll
    for (int j = 0; j < 8; ++j) *(unsigned*)(p + 4 * lane + 256 * j) = pack4_fp8(v[j][0] * s, v[j][1] * s, v[j][2] * s, v[j][3] * s);
}
__device__ __forceinline__ void rows_norm_only(const float* x, const float* g, bf16* H, unsigned char* H8, const float* w_in, const float* bforget, float* LF, LAS unsigned char* lds, int tid, int gw, int NGW, int lane) {
    fc_stage(w_in, lds, tid);
    f32x4 gv[8]; ld_row_f32(g, lane, gv);
    for (int m = gw; m < T_TOK; m += NGW) { f32x4 v[8]; ld_row_f32(x + (size_t)m * DM, lane, v); const float r = row_rstd(v);
#pragma unroll
        for (int j = 0; j < 8; ++j) v[j] = (v[j] * r) * gv[j];
        st_row_bf16(H + (size_t)m * DM, lane, v);
        if (H8) st_row_fp8(H8 + (size_t)m * DM, lane, v, F8_SH);
        fc_row(v, lds, bforget, LF + (size_t)m * 16, lane); }
}
constexpr int RT_W = 0, RT_CNT = 65536, RT_BASE = 65536 + 64, RT_ROW = 65536 + 128;
template <bool ROUTE, bool XINB>
__device__ __forceinline__ void rows_post_mixer(const void* xin, bf16* xout, const bf16* Mo, const float* g1, const float* g2, bf16* H, const float* w_router,
                                                unsigned* ecnt, int* list, float* tokinfo, LAS unsigned char* lds, int r0, int r1, int tid) {
    const int lane = tid & 63, wave = __builtin_amdgcn_readfirstlane(tid >> 6);
    if (ROUTE) {
        LAS float* wl = (LAS float*)(lds + RT_W);
        for (int k = tid; k < DM; k += 512) { const f32x4 a = *(const f32x4*)(w_router + (size_t)k * 8), b = *(const f32x4*)(w_router + (size_t)k * 8 + 4);
            wl[0 * DM + k] = a[0]; wl[1 * DM + k] = a[1]; wl[2 * DM + k] = a[2]; wl[3 * DM + k] = a[3]; wl[4 * DM + k] = b[0]; wl[5 * DM + k] = b[1]; wl[6 * DM + k] = b[2]; wl[7 * DM + k] = b[3]; }
        if (tid < 8) ((LAS unsigned*)(lds + RT_CNT))[tid] = 0u;
        __syncthreads();
    }
    f32x4 gv1[8], gv2[8]; ld_row_f32(g1, lane, gv1); ld_row_f32(g2, lane, gv2);
    for (int m = r0 + wave; m < r1; m += NWAVES) {
        f32x4 v[8], xv[8]; ld_row_bf16(Mo + (size_t)m * DM, lane, v);
        if (XINB) ld_row_bf16((const bf16*)xin + (size_t)m * DM, lane, xv); else ld_row_f32((const float*)xin + (size_t)m * DM, lane, xv);
        const float r = row_rstd(v);
#pragma unroll
        for (int j = 0; j < 8; ++j) xv[j] = xv[j] + (v[j] * r) * gv1[j];
        st_row_bf16(xout + (size_t)m * DM, lane, xv);
        const float r2 = row_rstd(xv);
#pragma unroll
        for (int j = 0; j < 8; ++j) v[j] = (xv[j] * r2) * gv2[j];
        if (ROUTE) {
#pragma unroll
            for (int j = 0; j < 8; ++j) *(unsigned*)((unsigned char*)H + (size_t)m * DM + 4 * lane + 256 * j) = pack4_fp8(v[j][0] * F8_SH, v[j][1] * F8_SH, v[j][2] * F8_SH, v[j][3] * F8_SH);
        } else st_row_bf16(H + (size_t)m * DM, lane, v);
        if (ROUTE) {
            const LAS float* wl = (const LAS float*)(lds + RT_W);
            float lg[8];
#pragma unroll
            for (int e = 0; e < 8; ++e) { float s = 0.f;
#pragma unroll
                for (int j = 0; j < 8; ++j) { const f32x4 w = *(const LAS f32x4*)(wl + e * DM + 4 * lane + 256 * j); s += (v[j][0] * w[0] + v[j][1] * w[1]) + (v[j][2] * w[2] + v[j][3] * w[3]); }
                lg[e] = wave_sum(s); }
            if (lane == 0) {
                int i1 = 0; float v1 = lg[0];
#pragma unroll
                for (int e = 1; e < 8; ++e) if (lg[e] > v1) { v1 = lg[e]; i1 = e; }
                int i2 = -1; float v2 = -INFINITY;
#pragma unroll
                for (int e = 0; e < 8; ++e) if (e != i1 && (i2 < 0 || lg[e] > v2)) { v2 = lg[e]; i2 = e; }
                const float ex = expf(v2 - v1), w1 = 1.f / (1.f + ex), w2 = ex * w1;
                LAS unsigned* lc = (LAS unsigned*)(lds + RT_CNT);
                const unsigned lp1 = __hip_atomic_fetch_add(&lc[i1], 1u, __ATOMIC_RELAXED, __HIP_MEMORY_SCOPE_WORKGROUP), lp2 = __hip_atomic_fetch_add(&lc[i2], 1u, __ATOMIC_RELAXED, __HIP_MEMORY_SCOPE_WORKGROUP);
                LAS unsigned* rr = (LAS unsigned*)(lds + RT_ROW) + (m - r0) * 8;
                rr[0] = (unsigned)i1; rr[1] = (unsigned)i2; rr[2] = lp1; rr[3] = lp2; rr[4] = __float_as_uint(w1); rr[5] = __float_as_uint(w2);
            }
        }
    }
    if (ROUTE) {
        __syncthreads();
        if (tid < 8) { const unsigned c = ((LAS unsigned*)(lds + RT_CNT))[tid]; ((LAS unsigned*)(lds + RT_BASE))[tid] = c ? __hip_atomic_fetch_add(ecnt + tid, c, __ATOMIC_RELAXED, __HIP_MEMORY_SCOPE_AGENT) : 0u; }
        __syncthreads();
        for (int i = tid; i < r1 - r0; i += 512) { const LAS unsigned* rr = (const LAS unsigned*)(lds + RT_ROW) + i * 8; const LAS unsigned* bs = (const LAS unsigned*)(lds + RT_BASE);
            const unsigned e1 = rr[0], e2 = rr[1], p1 = bs[e1] + rr[2], p2 = bs[e2] + rr[3]; const int tok = r0 + i;
            list[(size_t)e1 * CAP + p1] = tok; list[(size_t)e2 * CAP + p2] = tok;
            f32x4 a, b; a[0] = __uint_as_float(e1); a[1] = __uint_as_float(p1); a[2] = __uint_as_float(e2); a[3] = __uint_as_float(p2); b[0] = __uint_as_float(rr[4]); b[1] = __uint_as_float(rr[5]); b[2] = 0.f; b[3] = 0.f;
            *(f32x4*)(tokinfo + (size_t)tok * 8) = a; *(f32x4*)(tokinfo + (size_t)tok * 8 + 4) = b; }
        __syncthreads();
    }
}
template <bool MOE, bool NEXTH>
__device__ __forceinline__ void rows_post_ffn(bf16* xb, float* xfinal, const bf16* F, const float* tokinfo, const LAS int* tbl, const float* g1, const float* g2, bf16* H, unsigned char* H8, const float* w_in, const float* bforget, float* LF, LAS unsigned char* lds, int tid, int gw, int NGW, int lane) {
    if (NEXTH) fc_stage(w_in, lds, tid);
    f32x4 gv1[8], gv2[8]; ld_row_f32(g1, lane, gv1); if (NEXTH) ld_row_f32(g2, lane, gv2);
    for (int m = gw; m < T_TOK; m += NGW) {
        f32x4 v[8], xv[8];
        if (MOE) { const f32x4 a = *(const f32x4*)(tokinfo + (size_t)m * 8); const f32x2 wv = *(const f32x2*)(tokinfo + (size_t)m * 8 + 4);
            const int e1 = (int)__float_as_uint(a[0]), p1 = (int)__float_as_uint(a[1]), e2 = (int)__float_as_uint(a[2]), p2 = (int)__float_as_uint(a[3]);
            const size_t s1 = (size_t)tbl[e1] * 256 + p1, s2 = (size_t)tbl[e2] * 256 + p2;
            const unsigned char* Y8 = (const unsigned char*)F; const float w1s = wv[0] * (1.f / F8_SY), w2s = wv[1] * (1.f / F8_SY);
#pragma unroll
            for (int j = 0; j < 8; ++j) { const unsigned a8 = *(const unsigned*)(Y8 + s1 * DM + 4 * lane + 256 * j), b8 = *(const unsigned*)(Y8 + s2 * DM + 4 * lane + 256 * j);
                const f32x2 al = __builtin_amdgcn_cvt_pk_f32_fp8((int)a8, false), ah = __builtin_amdgcn_cvt_pk_f32_fp8((int)a8, true), bl = __builtin_amdgcn_cvt_pk_f32_fp8((int)b8, false), bh = __builtin_amdgcn_cvt_pk_f32_fp8((int)b8, true);
                v[j] = (f32x4){al[0] * w1s + bl[0] * w2s, al[1] * w1s + bl[1] * w2s, ah[0] * w1s + bh[0] * w2s, ah[1] * w1s + bh[1] * w2s}; }
        } else ld_row_bf16(F + (size_t)m * DM, lane, v);
        ld_row_bf16(xb + (size_t)m * DM, lane, xv);
        const float r = row_rstd(v);
#pragma unroll
        for (int j = 0; j < 8; ++j) xv[j] = xv[j] + (v[j] * r) * gv1[j];
        if (NEXTH) st_row_bf16(xb + (size_t)m * DM, lane, xv); else st_row_f32(xfinal + (size_t)m * DM, lane, xv);
        if (NEXTH) { const float r2 = row_rstd(xv);
#pragma unroll
            for (int j = 0; j < 8; ++j) v[j] = (xv[j] * r2) * gv2[j];
            st_row_bf16(H + (size_t)m * DM, lane, v);
            if (H8) st_row_fp8(H8 + (size_t)m * DM, lane, v, F8_SH);
            fc_row(v, lds, bforget, LF + (size_t)m * 16, lane); }
    }
}

constexpr int N_PHASES = 17;
__global__ void __launch_bounds__(NWAVES * 64, 2) mk_fwd(Args args) {
    extern __shared__ __attribute__((aligned(16))) unsigned char lds_raw[];
    LAS unsigned char* lds = (LAS unsigned char*)lds_raw;
    volatile LAS unsigned* MISC = (volatile LAS unsigned*)(lds + MISC_OFF);
    const int wave_s = __builtin_amdgcn_readfirstlane((int)threadIdx.x >> 6);
#define TID_NOW() ({ int z_ = 0; asm volatile("" : "+v"(z_)); wave_s * 64 + (int)__builtin_amdgcn_mbcnt_hi(~0u, __builtin_amdgcn_mbcnt_lo(~0u, (unsigned)z_)); })
    const int G = gridDim.x; const int bx = blockIdx.x; const int vcu = (G % 8 == 0) ? (bx % 8) * (G / 8) + bx / 8 : bx;
    const int NGW = G * NWAVES;
    auto ptid = [wave_s]() __attribute__((always_inline)) { int z_ = 0; asm volatile("" : "+v"(z_)); return wave_s * 64 + (int)__builtin_amdgcn_mbcnt_hi(~0u, __builtin_amdgcn_mbcnt_lo(~0u, (unsigned)z_)); };
    const Args& P = args;
    unsigned* ctl0 = (unsigned*)(P.ws + WS_CTL);
    for (int u = TID_NOW(); u < (LDS_BYTES - LDSCTL_OFF) / 4; u += NWAVES * 64) ((LAS unsigned*)(lds + LDSCTL_OFF))[u] = 0u;
    __syncthreads();
    XcdBarrier bar; bar.bar = ctl0 + CW_BAR; bar.x = 0; bar.st = nullptr;
    if (MK_N_LAUNCHES == 1) bar = xcd_barrier_post(ctl0 + CW_BAR, MISC + 8, TID_NOW() == 0);
#define GRID_BAR() do { if (MK_N_LAUNCHES == 1) xcd_barrier(bar, TID_NOW() == 0); } while (0)
    const int lo = args.ph_lo, hi = args.ph_hi;
#define IN(k) (lo <= (k) && (k) < hi)
#define BOTH(k) (IN(k) && IN((k) + 1))

#define WS_VIEWS() unsigned char* ws_ = P.ws; asm volatile("" : "+s"(ws_)); \
    bf16* H = (bf16*)(ws_ + WS_H); bf16* Z = (bf16*)(ws_ + WS_Z); bf16* Gt = (bf16*)(ws_ + WS_G); bf16* O = (bf16*)(ws_ + WS_O); bf16* MG = (bf16*)(ws_ + WS_MG); \
    bf16* U = (bf16*)(ws_ + WS_U); bf16* Mo = (bf16*)(ws_ + WS_MO); bf16* Y = (bf16*)(ws_ + WS_Y); float* LF = (float*)(ws_ + WS_LF); \
    int* list = (int*)(ws_ + WS_LIST); float* tokinfo = (float*)(ws_ + WS_TOK); unsigned* ctl = (unsigned*)(ws_ + WS_CTL); \
    (void)H; (void)Z; (void)Gt; (void)O; (void)MG; (void)U; (void)Mo; (void)Y; (void)LF; (void)list; (void)tokinfo; (void)ctl
    LAS int* tbl = (LAS int*)(lds + LDSCTL_OFF);

    if (IN(0)) { WS_VIEWS();
        { const int t = ptid(), lane = t & 63, wave = __builtin_amdgcn_readfirstlane(t >> 6), gw = vcu * NWAVES + wave;
          p0_prologue(P, lds, gw, NGW, wave, lane);
          if (MK_PROBE_DUP == 1) { asm volatile("" ::: "memory"); p0_prologue(P, lds, gw, NGW, wave, lane); }
          __syncthreads();
          rows_norm_only(P.in[0], P.in[1], H, (MK_FP8_GATES & 1) ? ws_ + WS_H8 : nullptr, P.in[2], P.in[3], LF, lds, t, gw, NGW, lane); }
        if (BOTH(0)) GRID_BAR();
    }
    for (int layer = 0; layer < 2; ++layer) {
        const int pb = 1 + 8 * layer;
        if (IN(pb + 0)) { WS_VIEWS();
            const bf16* win_t = (const bf16*)(ws_ + WS_WIN) + (size_t)layer * NIN * DM;
            if ((MK_FP8_GATES >> layer) & 1) {
                { pg8::Gemm g{H, win_t, DM}; pg8::StaticOrder S; S.init(T_TOK / 256, 20, G, bx); pg8::EpiPlain E{Z, ZP, 1.f};
                  pg8::gemm_phase(ptid(), lds + RING_OFF, g, S, E); }
                { pg8::Gemm g{(const bf16*)(ws_ + WS_H8), win_t + (size_t)5120 * DM, DM / 2}; pg8::StaticOrder S; S.init(T_TOK / 256, 24, G, bx); pg8::EpiGates E{(unsigned char*)Gt, P.in[4] + (size_t)layer * GP, F8_GT_INV};
                  pg8::gemm_phase<pg8::EpiGates, pg8::StaticOrder, true>(ptid(), lds + RING_OFF, g, S, E); }
            } else {
                pg8::Gemm g{H, win_t, DM}; pg8::StaticOrder S; S.init(T_TOK / 256, 44, G, bx);
                pg8::EpiInProj E{Z, (unsigned char*)Gt, P.in[4] + (size_t)layer * GP};
                pg8::gemm_phase(ptid(), lds + RING_OFF, g, S, E);
            }
            if (BOTH(pb + 0)) GRID_BAR();
        }
        if (IN(pb + 1)) { WS_VIEWS();
            const int t = ptid(), lane = t & 63;
            att::Args A; A.Z = Z; A.O = O; A.LF = LF; A.sinks = P.in[5] + layer * 12; A.subln = P.in[10] + layer * 128;
            { float s1 = P.in[6][layer * 64 + lane] * P.in[7][layer * 64 + lane], s2 = P.in[8][layer * 64 + lane] * P.in[9][layer * 64 + lane];
              s1 = wave_sum(s1); s2 = wave_sum(s2);
              A.lam_init = 0.8f - 0.6f * expf(-0.3f * (float)layer); A.lam = expf(s1) - expf(s2) + A.lam_init; }
            unsigned* qhead = ctl + CW_ATTQ + 64 * layer;
            const unsigned nconv = layer ? (unsigned)CONV_L1_UNITS : (unsigned)CONV_L0_UNITS, NGRP = (nconv + 2u) / 3u, NQ1 = NGRP * 7u, NQ = NQ1 + ((unsigned)att::NUNITS - NGRP * 4u);
            static_assert(((CONV_L0_UNITS + 2) / 3) * 4 <= att::NUNITS && ((CONV_L1_UNITS + 2) / 3) * 4 <= att::NUNITS, "queue interleave");
            unsigned nxt = 0u; if (t == 0) nxt = __hip_atomic_fetch_add(qhead, 1u, __ATOMIC_RELAXED, __HIP_MEMORY_SCOPE_AGENT);
            for (;;) {
                if (t == 0) MISC[0] = nxt;
                __syncthreads();
                unsigned idx = MISC[0];
                __syncthreads();
                if (idx >= NQ * (MK_PROBE_DUP == 2 ? 4u : 1u)) break;
                if (t == 0) nxt = __hip_atomic_fetch_add(qhead, 1u, __ATOMIC_RELAXED, __HIP_MEMORY_SCOPE_AGENT);
                if (MK_PROBE_DUP == 2) idx %= NQ;
                int au = (int)(NGRP * 4u + (idx - NQ1)), cu = -1;
                if (idx < NQ1) { const unsigned grp = idx / 7u, rem = idx - grp * 7u; au = (int)(grp * 4u + rem); if (rem >= 4u) cu = (int)(grp * 3u + (rem - 4u)); }
                if (cu < 0) att::attn_unit(t, A, lds + RING_OFF, au);
                else if ((unsigned)cu < nconv) conv_unit(P, lds, layer, cu, __builtin_amdgcn_readfirstlane(t >> 6), lane);
            }
            if (BOTH(pb + 1)) GRID_BAR();
        }
        if (IN(pb + 2)) { WS_VIEWS();
            pg8::Gemm g{O, (const bf16*)(P.ws + WS_WBR) + (size_t)layer * DM * DM, DM}; pg8::StaticOrder S; S.init(T_TOK / 256, DM / 256, G, bx);
            pg8::EpiBranch E{(const unsigned char*)Gt, MG};
            int nrep = (MK_PROBE_DUP == 6) ? 2 : 1; asm volatile("" : "+s"(nrep));
            for (int rep = 0; rep < nrep; ++rep) pg8::gemm_phase(ptid(), lds + RING_OFF, g, S, E);
            if (BOTH(pb + 2)) GRID_BAR();
        }
        if (IN(pb + 3)) { WS_VIEWS();
            pg8::Gemm g{MG, (const bf16*)(P.ws + WS_WOUT) + (size_t)layer * DM * DM, DM}; pg8::StaticOrder S; S.init(T_TOK / 256, DM / 256, G, bx);
            pg8::EpiPlain E{Mo, DM, 1.f};
            int nrep = (MK_PROBE_DUP == 6) ? 2 : 1; asm volatile("" : "+s"(nrep));
            for (int rep = 0; rep < nrep; ++rep) pg8::gemm_phase(ptid(), lds + RING_OFF, g, S, E);
            if (BOTH(pb + 3)) GRID_BAR();
        }
        if (IN(pb + 4)) { WS_VIEWS();
            const int rpb = (T_TOK + G - 1) / G, r0 = vcu * rpb, r1 = (r0 + rpb < T_TOK) ? r0 + rpb : T_TOK;
            bf16* XB = (bf16*)(ws_ + WS_XB);
            if (layer == 0) rows_post_mixer<false, false>(P.in[0], XB, Mo, P.in[15] + layer * DM, P.in[16] + layer * DM, H, nullptr, nullptr, nullptr, nullptr, lds, r0, r1, ptid());
            else            rows_post_mixer<true, true>(XB, XB, Mo, P.in[15] + layer * DM, P.in[16] + layer * DM, H, P.in[21], ctl + CW_ECNT, list, tokinfo, lds, r0, r1, ptid());
            if (BOTH(pb + 4)) GRID_BAR();
        }
        if (layer == 0) {
            if (IN(pb + 5)) { WS_VIEWS();
                pg8::Gemm g{H, (const bf16*)(P.ws + WS_WGU), DM}; pg8::StaticOrder S; S.init(T_TOK / 256, 2 * DFF / 256, G, bx);
                if (MK_FP8_DDOWN) { pg8::EpiSwiGLU8 E{(unsigned char*)U, DFF, 1.f, F8_SU}; pg8::gemm_phase(ptid(), lds + RING_OFF, g, S, E); }
                else { pg8::EpiSwiGLU E{U, DFF}; pg8::gemm_phase(ptid(), lds + RING_OFF, g, S, E); }
                if (BOTH(pb + 5)) GRID_BAR();
            }
            if (IN(pb + 6)) { WS_VIEWS();
                if (MK_FP8_DDOWN) { pg8::Gemm g{U, (const bf16*)(P.ws + WS_WD), DFF / 2}; pg8::StaticOrder S; S.init(T_TOK / 256, DM / 256, G, bx);
                    pg8::EpiPlain E{Mo, DM, F8_DN_INV}; pg8::gemm_phase<pg8::EpiPlain, pg8::StaticOrder, true>(ptid(), lds + RING_OFF, g, S, E); }
                else { pg8::Gemm g{U, (const bf16*)(P.ws + WS_WD), DFF}; pg8::StaticOrder S; S.init(T_TOK / 256, DM / 256, G, bx);
                    pg8::EpiPlain E{Mo, DM, 1.f}; pg8::gemm_phase(ptid(), lds + RING_OFF, g, S, E); }
                if (BOTH(pb + 6)) GRID_BAR();
            }
            if (IN(pb + 7)) { WS_VIEWS();
                const int t = ptid(), lane = t & 63, gw = vcu * NWAVES + __builtin_amdgcn_readfirstlane(t >> 6);
                rows_post_ffn<false, true>((bf16*)(ws_ + WS_XB), nullptr, Mo, nullptr, tbl, P.in[17] + layer * DM, P.in[1] + (layer + 1) * DM, H, (MK_FP8_GATES & 2) ? ws_ + WS_H8 : nullptr, P.in[2] + (size_t)(layer + 1) * DM * DIN_SRC, P.in[3] + (layer + 1) * 12, LF, lds, t, gw, NGW, lane);
                if (BOTH(pb + 7)) GRID_BAR();
            }
        } else {
            if (IN(pb + 5) || IN(pb + 6) || IN(pb + 7)) { WS_VIEWS();
                if (TID_NOW() == 0) { int ts = 0;
                    for (int e = 0; e < 8; ++e) { const int c = (int)__hip_atomic_load(ctl + CW_ECNT + e, __ATOMIC_RELAXED, __HIP_MEMORY_SCOPE_AGENT); tbl[e] = ts; tbl[16 + e] = c; ts += (c + 255) >> 8; }
                    tbl[8] = ts; }
                __syncthreads();
            }
            if (IN(pb + 5)) { WS_VIEWS();
                pg8::Gemm g{H, (const bf16*)(P.ws + WS_EGU), DM / 2}; pg8::MoeOrder<true> S; S.init(__builtin_amdgcn_readfirstlane(tbl[8]), 2 * DFE / 256, G, bx); S.tbl = tbl; S.list = list;
                pg8::EpiSwiGLU8 E{(unsigned char*)U, DFE, F8_UP_INV, F8_UP_INV * F8_SU};
                int nrep = (MK_PROBE_DUP == 4) ? 2 : 1; asm volatile("" : "+s"(nrep));
                for (int rep = 0; rep < nrep; ++rep) pg8::gemm_phase<pg8::EpiSwiGLU8, pg8::MoeOrder<true>, true>(ptid(), lds + RING_OFF, g, S, E);
                if (BOTH(pb + 5)) GRID_BAR();
            }
            if (IN(pb + 6)) { WS_VIEWS();
                pg8::Gemm g{U, (const bf16*)(P.ws + WS_ED), DFE / 2}; pg8::MoeOrder<false> S; S.init(__builtin_amdgcn_readfirstlane(tbl[8]), DM / 256, G, bx); S.tbl = tbl; S.list = list;
                pg8::EpiPlain8 E{(unsigned char*)Y, DM, F8_DN_INV * F8_SY};
                int nrep = (MK_PROBE_DUP == 5) ? 2 : 1; asm volatile("" : "+s"(nrep));
                for (int rep = 0; rep < nrep; ++rep) pg8::gemm_phase<pg8::EpiPlain8, pg8::MoeOrder<false>, true>(ptid(), lds + RING_OFF, g, S, E);
                if (BOTH(pb + 6)) GRID_BAR();
            }
            if (IN(pb + 7)) { WS_VIEWS();
                const int t = ptid(), lane = t & 63, gw = vcu * NWAVES + __builtin_amdgcn_readfirstlane(t >> 6);
                rows_post_ffn<true, false>((bf16*)(ws_ + WS_XB), P.out, Y, tokinfo, tbl, P.in[17] + layer * DM, nullptr, nullptr, nullptr, nullptr, nullptr, nullptr, lds, t, gw, NGW, lane);
            }
        }
    }
#undef IN
#undef BOTH
#undef GRID_BAR
}

__global__ void dbg_dump(const bf16* buf, int pitch, float* out) {
    const size_t i = (size_t)blockIdx.x * blockDim.x + threadIdx.x; const size_t row = i / DM; const int c = (int)(i % DM);
    float s = 0.f; for (int k = c; k < pitch; k += DM) s += bf_lo((unsigned)buf[row * pitch + k]);
    out[i] = s;
}
#ifndef MK_DUMP
#define MK_DUMP 0
#endif
extern "C" void kernel_launch(void* const* d_in, const int* in_sizes, int n_in, void* d_out, int out_size, void* d_ws, size_t ws_size, hipStream_t stream) {
    static int grid = 0;
    if (grid == 0) {
        if (n_in != 25 || in_sizes[0] != T_TOK * DM || out_size != T_TOK * DM || ws_size < WS_END) { fprintf(stderr, "kernel_launch: unexpected problem shape (n_in %d, in0 %d, out %d, ws %zu < %zu)\n", n_in, n_in > 0 ? in_sizes[0] : -1, out_size, ws_size, (size_t)WS_END); grid = -1; return; }
        int dev = 0, cus = 0, per_cu = 0;
        if (hipGetDevice(&dev) != hipSuccess || hipDeviceGetAttribute(&cus, hipDeviceAttributeMultiprocessorCount, dev) != hipSuccess) { grid = -1; return; }
        if (hipFuncSetAttribute((const void*)mk_fwd, hipFuncAttributeMaxDynamicSharedMemorySize, LDS_BYTES) != hipSuccess) { fprintf(stderr, "kernel_launch: hipFuncSetAttribute failed\n"); grid = -1; return; }
        if (hipOccupancyMaxActiveBlocksPerMultiprocessor(&per_cu, (const void*)mk_fwd, NWAVES * 64, LDS_BYTES) != hipSuccess || per_cu < 1) fprintf(stderr, "kernel_launch: occupancy query reports %d\n", per_cu);
        (void)hipGetLastError();
        grid = cus;
    }
    if (grid < 0) return;
    if (hipMemsetAsync((char*)d_ws + WS_CTL, 0, CTL_ZERO_BYTES, stream) != hipSuccess) return;
    Args a{};
    for (int i = 0; i < 25; ++i) a.in[i] = (const float*)d_in[i];
    a.out = (float*)d_out; a.ws = (unsigned char*)d_ws;
#if MK_N_LAUNCHES == 1
    a.ph_lo = 0; a.ph_hi = (N_PHASES < MK_STOP_PHASE) ? N_PHASES : MK_STOP_PHASE;
    hipLaunchKernelGGL(mk_fwd, dim3(grid), dim3(NWAVES * 64), LDS_BYTES, stream, a);
#else
    for (int p = 0; p < N_PHASES && p < MK_STOP_PHASE; ++p) { a.ph_lo = p; a.ph_hi = p + 1; hipLaunchKernelGGL(mk_fwd, dim3(grid), dim3(NWAVES * 64), LDS_BYTES, stream, a); }
    if (MK_DUMP) { const unsigned char* w = (const unsigned char*)d_ws; const bf16* b = nullptr; int pitch = DM;
        if (MK_DUMP == 1) { b = (const bf16*)(w + WS_Z); pitch = ZP; } if (MK_DUMP == 2) { b = (const bf16*)(w + WS_G); pitch = GP; } if (MK_DUMP == 3) b = (const bf16*)(w + WS_O);
        if (MK_DUMP == 4) b = (const bf16*)(w + WS_MG); if (MK_DUMP == 5) b = (const bf16*)(w + WS_MO); if (MK_DUMP == 6) b = (const bf16*)(w + WS_H);
        hipLaunchKernelGGL(dbg_dump, dim3(T_TOK * DM / 256), dim3(256), 0, stream, b, pitch, (float*)d_out); }
#endif
}
```

```cpp
#include <hip/hip_runtime.h>
#include <cstdio>
#include <cstdint>

#define LAS __attribute__((address_space(3)))
#define GAS __attribute__((address_space(1)))
typedef unsigned short bf16;
typedef short bf16x8 __attribute__((ext_vector_type(8)));
typedef short s16x4 __attribute__((ext_vector_type(4)));
typedef float f32x2 __attribute__((ext_vector_type(2)));
typedef float f32x4 __attribute__((ext_vector_type(4)));
typedef float f32x16 __attribute__((ext_vector_type(16)));
typedef unsigned u32x2 __attribute__((ext_vector_type(2)));
typedef unsigned u32x4 __attribute__((ext_vector_type(4)));

#ifndef MK_STOP_PHASE
#define MK_STOP_PHASE 99
#endif
#ifndef MK_FP8_GATES
#define MK_FP8_GATES 3
#endif
#ifndef MK_FP8_DDOWN
#define MK_FP8_DDOWN 1
#endif
#ifndef MK_PROBE_DUP
#define MK_PROBE_DUP 0
#endif
#ifndef MK_N_LAUNCHES
#define MK_N_LAUNCHES 1
#endif

constexpr int T_TOK = 16384, DM = 2048, SEQ = 2048, NBATCH = 8;
constexpr int ZP = 5120;
constexpr int GP = 6144;
constexpr int NIN = 11520;
constexpr int DIN_SRC = 11276;
constexpr int DFF = 5632, DFE = 7168, NEXP = 8;
constexpr int CAP = 16384;
constexpr int SLOT_ROWS = 32768 + 2048;
constexpr float RMS_EPS = 1e-6f;
constexpr float LOG2E = 1.4426950408889634f;
constexpr float QSCALE = 0.125f * LOG2E;

constexpr size_t MiB = 1u << 20;
constexpr size_t WS_CTL = 0, CTL_ZERO_BYTES = 1 * MiB;
constexpr size_t WS_WIN = 1 * MiB;
constexpr size_t WS_WBR = WS_WIN + 90 * MiB;
constexpr size_t WS_WOUT = WS_WBR + 16 * MiB;
constexpr size_t WS_WGU = WS_WOUT + 16 * MiB;
constexpr size_t WS_WD = WS_WGU + 44 * MiB;
constexpr size_t WS_EGU = WS_WD + 22 * MiB;
constexpr size_t WS_ED = WS_EGU + 448 * MiB;
constexpr size_t WS_H = WS_ED + 224 * MiB;
constexpr size_t WS_Z = WS_H + 64 * MiB;
constexpr size_t WS_G = WS_Z + 160 * MiB;
constexpr size_t WS_O = WS_G + 192 * MiB;
constexpr size_t WS_MG = WS_O + 64 * MiB;
constexpr size_t WS_U = WS_Z;
constexpr size_t WS_MO = WS_MG + 64 * MiB;
constexpr size_t WS_Y = WS_MO + 64 * MiB;
constexpr size_t WS_LF = WS_Y + 136 * MiB;
constexpr size_t WS_LIST = WS_LF + 1 * MiB;
constexpr size_t WS_TOK = WS_LIST + 512 * 1024;
constexpr size_t WS_XB = WS_TOK + 512 * 1024;
constexpr size_t WS_H8 = WS_XB + 64 * MiB;
constexpr size_t WS_END = WS_H8 + 32 * MiB;
static_assert((size_t)SLOT_ROWS * DFE * 2 <= 480 * MiB, "MoE hidden fits the overlay");
constexpr int CW_TMO = 0, CW_CODE = 1;
constexpr int CW_BAR = 4096;
constexpr int CW_ATTQ = 8192;
constexpr int CW_ECNT = 8192 + 256;
constexpr int CW_MD = 8192 + 512;

constexpr int RING_OFF = 0, RING_BYTES = 131072;
constexpr int LDSCTL_OFF = RING_BYTES, MISC_OFF = LDSCTL_OFF + 320;
constexpr int LDS_BYTES = 155648;
constexpr int NWAVES = 8;

typedef __bf16 bf16x2_t __attribute__((ext_vector_type(2)));
__device__ __forceinline__ unsigned cvt_pk_bf16(float lo, float hi) { const f32x2 v = {lo, hi}; const bf16x2_t b = __builtin_convertvector(v, bf16x2_t); return __builtin_bit_cast(unsigned, b); }
__device__ __forceinline__ float bf_lo(unsigned w) { return __builtin_bit_cast(float, w << 16); }
__device__ __forceinline__ float bf_hi(unsigned w) { return __builtin_bit_cast(float, w & 0xffff0000u); }
template <int X> __device__ __forceinline__ float swz_xor(float v) { return __int_as_float(__builtin_amdgcn_ds_swizzle(__float_as_int(v), 0x1f | (X << 10))); }
__device__ __forceinline__ float wave_sum(float v) {
    v += swz_xor<1>(v); v += swz_xor<2>(v); v += swz_xor<4>(v); v += swz_xor<8>(v); v += swz_xor<16>(v);
    const auto rr = __builtin_amdgcn_permlane32_swap(__float_as_uint(v), __float_as_uint(v), false, false);
    return __uint_as_float(rr[0]) + __uint_as_float(rr[1]);
}
__device__ __forceinline__ float wave_incl_scan(float v, int lane, float& total) {
    float pre = v, tot = v, t;
    t = swz_xor<1>(tot);  if (lane & 1)  pre += t; tot += t;
    t = swz_xor<2>(tot);  if (lane & 2)  pre += t; tot += t;
    t = swz_xor<4>(tot);  if (lane & 4)  pre += t; tot += t;
    t = swz_xor<8>(tot);  if (lane & 8)  pre += t; tot += t;
    t = swz_xor<16>(tot); if (lane & 16) pre += t; tot += t;
    const auto rr = __builtin_amdgcn_permlane32_swap(__float_as_uint(tot), __float_as_uint(tot), false, false);
    if (lane & 32) pre += __uint_as_float(rr[0]);
    total = __uint_as_float(rr[0]) + __uint_as_float(rr[1]);
    return pre;
}
__device__ __forceinline__ unsigned pack4_fp8(float a, float b, float c, float d) {
    a = fminf(fmaxf(a, -448.f), 448.f); b = fminf(fmaxf(b, -448.f), 448.f); c = fminf(fmaxf(c, -448.f), 448.f); d = fminf(fmaxf(d, -448.f), 448.f);
    int w = 0; w = __builtin_amdgcn_cvt_pk_fp8_f32(a, b, w, false); w = __builtin_amdgcn_cvt_pk_fp8_f32(c, d, w, true); return (unsigned)w; }
constexpr float F8_SWG = 64.f, F8_GT_INV = 1.f / 1024.f;
constexpr float F8_SY = 16.f;
constexpr float F8_SH = 16.f, F8_SWU = 64.f, F8_SU = 8.f, F8_SWD = 128.f, F8_UP_INV = 1.f / 1024.f, F8_DN_INV = 1.f / 1024.f;
typedef int v8i __attribute__((ext_vector_type(8)));
typedef short s16x16 __attribute__((ext_vector_type(16)));
__device__ __forceinline__ v8i cat8(bf16x8 a, bf16x8 b) { const s16x16 c = __builtin_shufflevector(a, b, 0, 1, 2, 3, 4, 5, 6, 7, 8, 9, 10, 11, 12, 13, 14, 15); return __builtin_bit_cast(v8i, c); }
__device__ __forceinline__ bf16x8 lo8(v8i v) { const s16x16 c = __builtin_bit_cast(s16x16, v); return __builtin_shufflevector(c, c, 0, 1, 2, 3, 4, 5, 6, 7); }
__device__ __forceinline__ bf16x8 hi8(v8i v) { const s16x16 c = __builtin_bit_cast(s16x16, v); return __builtin_shufflevector(c, c, 8, 9, 10, 11, 12, 13, 14, 15); }
__device__ __forceinline__ unsigned pack4_u8(float a, float b, float c, float d) {
    const float ta = fmaxf(__builtin_floorf(fmaf(a, 255.f, 0.5f)), 1.f), tb = fmaxf(__builtin_floorf(fmaf(b, 255.f, 0.5f)), 1.f), tc = fmaxf(__builtin_floorf(fmaf(c, 255.f, 0.5f)), 1.f), td = fmaxf(__builtin_floorf(fmaf(d, 255.f, 0.5f)), 1.f);
    return (unsigned)ta | ((unsigned)tb << 8) | ((unsigned)tc << 16) | ((unsigned)td << 24); }
__device__ __forceinline__ float ub(unsigned w, int k) { return (float)((w >> (8 * k)) & 0xffu); }
__device__ __forceinline__ float fast_sigmoid(float v) { return __builtin_amdgcn_rcpf(1.f + __builtin_amdgcn_exp2f(-LOG2E * v)); }

namespace pg8 {
constexpr int BM = 256, BK = 64, HALF = 128, HTB = HALF * BK * 2, STAGE_BYTES = 8 * HTB, NXCD = 8, WGM = 8;
__host__ __device__ __forceinline__ int lds_byte(int r, int c) { const int st = (r >> 4) * 2 + (c >> 5), rr = r & 15, cc = c & 31, ob = rr * 64 + cc * 2; return st * 1024 + (ob ^ (((ob >> 9) & 1) << 5)); }
__host__ __device__ __forceinline__ void stage_rc(int b, int& R, int& C) { const int st = b / 1024, sb = b % 1024, swz = sb ^ (((sb >> 9) & 1) << 5); R = (st >> 1) * 16 + swz / 64; C = (st & 1) * 32 + (swz % 64) / 2; }
__host__ __device__ __forceinline__ int perm32(int rho) { const int n = rho >> 4, i = rho & 15; return 8 * (i >> 2) + 4 * n + (i & 3); }

struct Unit { int pm, pn; };
struct Gemm { const bf16* A; const bf16* Bt; int K; };

struct StaticOrder {
    static constexpr bool GATHER = false;
    int nM, nN, nwg, G, c;
    __device__ __forceinline__ void init(int nM_, int nN_, int G_, int c_) { nM = nM_; nN = nN_; nwg = nM * nN; G = G_; c = c_; }
    __device__ __forceinline__ bool next(int i, Unit& u) const {
        const long L = (long)i * G + c; if (L >= nwg) return false;
        int wgid = (int)L; { const int q = nwg / NXCD, r = nwg % NXCD, xcd = wgid % NXCD, off = wgid / NXCD; wgid = (xcd < r ? xcd * (q + 1) : r * (q + 1) + (xcd - r) * q) + off; }
        const int nig = WGM * nN, gid = wgid / nig, fm = gid * WGM, gsz = (nM - fm) < WGM ? (nM - fm) : WGM;
        u.pm = fm + ((wgid % nig) % gsz); u.pn = (wgid % nig) / gsz; return true;
    }
    __device__ __forceinline__ int btile(const Unit& u) const { return u.pn; }
};
template <bool GATHER_> struct MoeOrder : StaticOrder {
    static constexpr bool GATHER = GATHER_;
    const LAS int* tbl; const int* list;
    __device__ __forceinline__ int expert(int pm) const { int e = 0;
#pragma unroll
        for (int j = 1; j < 8; ++j) e += (pm >= tbl[j]) ? 1 : 0;
        return __builtin_amdgcn_readfirstlane(e); }
    __device__ __forceinline__ int btile(const Unit& u) const { return expert(u.pm) * nN + u.pn; }
};

struct DownOrder : MoeOrder<false> {
    int nfull, nrem, nrem_units, pass;
    __device__ __forceinline__ void setup(int nMtot, int nN_, int G_, int c_) { nfull = (nMtot * nN_) / G_; const int rtf = nfull * G_ / nN_; nrem = nMtot - rtf; nrem_units = nrem * nN_; pass = 0; init(rtf, nN_, G_, c_); }
    __device__ __forceinline__ bool next(int i, Unit& u) const {
        if (pass == 0) { if (i >= nfull) return false; return StaticOrder::next(i, u); }
        if (i > 0 || c >= nrem_units) return false;
        u.pm = nM + c % nrem; u.pn = c / nrem; return true;
    }
};

template <class Sched> __device__ __forceinline__ void a_offsets(const Sched& S, const Unit& u, const int (&RA)[2], const int (&CA)[2], int K, unsigned (&o)[2][2]) {
    if constexpr (Sched::GATHER) {
        const int e = S.expert(u.pm), lb = __builtin_amdgcn_readfirstlane((u.pm - S.tbl[e]) * 256), cnt = __builtin_amdgcn_readfirstlane(S.tbl[16 + e]); const int* lp = S.list + (size_t)e * CAP;
        int tok[2][2];
#pragma unroll
        for (int h = 0; h < 2; ++h)
#pragma unroll
            for (int i = 0; i < 2; ++i) { const int lr = lb + h * HALF + RA[i]; tok[h][i] = (lr < cnt) ? lp[lr] : 0; }
#pragma unroll
        for (int h = 0; h < 2; ++h)
#pragma unroll
            for (int i = 0; i < 2; ++i) o[h][i] = (unsigned)tok[h][i] * (unsigned)(K * 2) + (unsigned)(CA[i] * 2);
    }
}

typedef f32x4 Acc[2][2][4][2];

template <class Epi, class Sched, bool FP8 = false>
__device__ __forceinline__ void gemm_phase(int tid, LAS unsigned char* lds, const Gemm g, const Sched& S, const Epi& E) {
    const int wid = __builtin_amdgcn_readfirstlane(tid >> 6), lane = tid & 63, wr = wid >> 2, wc = wid & 3, fr = lane & 15, fq = lane >> 4;
    const int K = g.K, nt = K / BK;
    unsigned voffB[2], voffA[2]; int RA[2], CA[2];
#pragma unroll
    for (int i = 0; i < 2; ++i) { int R, C; stage_rc(tid * 16 + i * 8192, R, C); const int Rb = (R & ~31) + perm32(R & 31);
        RA[i] = R; CA[i] = C; voffA[i] = (unsigned)(R * K + C) * 2u; voffB[i] = (unsigned)(((R >> 5) * 64 + perm32(R & 31)) * K + C) * 2u; (void)Rb; }
    const size_t kstep = (size_t)(BK * 2);
    const size_t hstep = (size_t)HALF * K * 2;
    const size_t tstep = 2 * hstep;
    const size_t hB = (size_t)32 * K * 2;
    const unsigned ldsw = (unsigned)wid * 1024u;
    const int aoff = lds_byte(wr * 64 + fr, fq * 8), boff = lds_byte(wc * 32 + fr, fq * 8);
#define PG8_SA(b, h) (((b) * 2 + (h)) * HTB)
#define PG8_SB(b, h) ((4 + (b) * 2 + (h)) * HTB)
#define PG8_STAGE_B(bufoff, gbase) do { _Pragma("unroll") for (int _i = 0; _i < 2; ++_i) \
        __builtin_amdgcn_global_load_lds((const unsigned*)((const char*)(gbase) + voffB[_i]), (LAS unsigned*)(lds + (bufoff) + ldsw + _i * 8192), 16, 0, 0); } while (0)
#define PG8_STAGE_A(bufoff, h, NX, kb) do { _Pragma("unroll") for (int _i = 0; _i < 2; ++_i) { const char* _p; \
        if constexpr (Sched::GATHER) _p = Ab + (kb) + ((NX) ? na[h][_i] : ca[h][_i]); else _p = ((NX) ? nA : cA) + (size_t)(h) * hstep + (kb) + voffA[_i]; \
        __builtin_amdgcn_global_load_lds((const unsigned*)_p, (LAS unsigned*)(lds + (bufoff) + ldsw + _i * 8192), 16, 0, 0); } } while (0)
#define PG8_LDA(dst, b, h) do { _Pragma("unroll") for (int m = 0; m < 4; ++m) dst[m] = cat8(*(const LAS bf16x8*)(lds + PG8_SA(b, h) + aoff + m * 2048), *(const LAS bf16x8*)(lds + PG8_SA(b, h) + aoff + m * 2048 + 1024)); } while (0)
#define PG8_LDB(dst, b, h) do { _Pragma("unroll") for (int n = 0; n < 2; ++n) dst[n] = cat8(*(const LAS bf16x8*)(lds + PG8_SB(b, h) + boff + n * 2048), *(const LAS bf16x8*)(lds + PG8_SB(b, h) + boff + n * 2048 + 1024)); } while (0)
#define PG8_MMA(ai, bj, At, Bt) do { __builtin_amdgcn_s_setprio(1); _Pragma("unroll") for (int m = 0; m < 4; ++m) _Pragma("unroll") for (int n = 0; n < 2; ++n) { \
        if constexpr (FP8) asm volatile("v_mfma_scale_f32_16x16x128_f8f6f4 %0, %1, %2, %0, %3, %3 op_sel_hi:[0,0,0]" : "+v"(acc[ai][bj][m][n]) : "v"(Bt[n]), "v"(At[m]), "v"(one_scale)); \
        else { acc[ai][bj][m][n] = __builtin_amdgcn_mfma_f32_16x16x32_bf16(lo8(Bt[n]), lo8(At[m]), acc[ai][bj][m][n], 0, 0, 0); \
               acc[ai][bj][m][n] = __builtin_amdgcn_mfma_f32_16x16x32_bf16(hi8(Bt[n]), hi8(At[m]), acc[ai][bj][m][n], 0, 0, 0); } } \
        __builtin_amdgcn_s_setprio(0); } while (0)
#define PG8_WAIT_V(n) asm volatile("s_waitcnt vmcnt(" #n ")" ::: "memory")
#define PG8_WAIT_L(n) asm volatile("s_waitcnt lgkmcnt(" #n ")" ::: "memory")
#define PG8_BAR __builtin_amdgcn_s_barrier()
#define PG8_SCHED __builtin_amdgcn_sched_barrier(0)
    Unit cur, nxt; int ui = 0;
    if (!S.next(0, cur)) return;
    Acc acc;
#pragma unroll
    for (int a = 0; a < 2; ++a)
#pragma unroll
        for (int b = 0; b < 2; ++b)
#pragma unroll
            for (int m = 0; m < 4; ++m)
#pragma unroll
                for (int n = 0; n < 2; ++n) acc[a][b][m][n] = (f32x4){0.f, 0.f, 0.f, 0.f};
    v8i At[4], B0[2], B1[2];
    int one_scale = 127; asm volatile("" : "+v"(one_scale));
#define PG8_MFMA_PAD() do { if constexpr (FP8) asm volatile("s_nop 15\n\ts_nop 7" ::: "memory"); } while (0)
    unsigned ca[2][2], na[2][2];
    const char* Ab = (const char*)g.A;
    const char* cA = Ab + (size_t)cur.pm * tstep; const char* nA = cA;
    if constexpr (Sched::GATHER) { a_offsets(S, cur, RA, CA, K, ca);
#pragma unroll
        for (int h = 0; h < 2; ++h)
#pragma unroll
            for (int i = 0; i < 2; ++i) na[h][i] = ca[h][i]; }
    const char* cB = (const char*)g.Bt + (size_t)S.btile(cur) * tstep;
    PG8_STAGE_B(PG8_SB(0, 0), cB); PG8_STAGE_B(PG8_SB(0, 1), cB + hB); PG8_STAGE_A(PG8_SA(0, 0), 0, false, (size_t)0); PG8_STAGE_A(PG8_SA(0, 1), 1, false, (size_t)0);
    if (wr == 1) PG8_BAR;
    PG8_WAIT_V(2); PG8_BAR;
    PG8_STAGE_B(PG8_SB(1, 0), cB + kstep); PG8_STAGE_A(PG8_SA(1, 0), 0, false, kstep); PG8_STAGE_B(PG8_SB(1, 1), cB + hB + kstep);
    PG8_WAIT_V(6); PG8_BAR;
    for (;;) {
        const bool has_next = S.next(ui + 1, nxt);
        if constexpr (Sched::GATHER) { if (has_next) a_offsets(S, nxt, RA, CA, K, na); }
        else nA = has_next ? Ab + (size_t)nxt.pm * tstep : cA;
        const char* nB = has_next ? (const char*)g.Bt + (size_t)S.btile(nxt) * tstep : cB;
        for (int t = 0; t < nt; t += 2) {
            const bool last = (t == nt - 2);
            if constexpr (Epi::MIDHOOK) { if (t == Epi::T1 || t == Epi::T2) E.mid(acc, cur, t, wr, wc, fr, fq); }
            const size_t a1k = (size_t)(t + 1) * kstep;
            const size_t a2k = last ? (size_t)0 : (size_t)(t + 2) * kstep, a3k = a2k + kstep;
            const char* b2 = last ? nB : cB + (size_t)(t + 2) * kstep; const char* b3 = b2 + kstep;
            PG8_LDB(B0, 0, 0); PG8_LDB(B1, 0, 1); PG8_SCHED; PG8_LDA(At, 0, 0); PG8_STAGE_A(PG8_SA(1, 1), 1, false, a1k);
            PG8_WAIT_V(8); PG8_WAIT_L(0); PG8_BAR; PG8_MMA(0, 0, At, B0); PG8_MMA(0, 1, At, B1); PG8_BAR; PG8_SCHED;
            PG8_LDA(At, 0, 1); PG8_STAGE_B(PG8_SB(0, 0), b2); PG8_STAGE_B(PG8_SB(0, 1), b2 + hB); PG8_STAGE_A(PG8_SA(0, 0), 0, last, a2k);
            PG8_WAIT_V(8); PG8_WAIT_L(0); PG8_BAR; PG8_MMA(1, 0, At, B0); PG8_MMA(1, 1, At, B1); PG8_BAR; PG8_SCHED;
            PG8_LDB(B0, 1, 0); PG8_LDB(B1, 1, 1); PG8_SCHED; PG8_LDA(At, 1, 0); PG8_STAGE_A(PG8_SA(0, 1), 1, last, a2k);
            PG8_WAIT_V(8); PG8_WAIT_L(0); PG8_BAR; PG8_MMA(0, 0, At, B0); PG8_MMA(0, 1, At, B1); PG8_BAR; PG8_SCHED;
            PG8_LDA(At, 1, 1); PG8_STAGE_B(PG8_SB(1, 0), b3); PG8_STAGE_B(PG8_SB(1, 1), b3 + hB); PG8_STAGE_A(PG8_SA(1, 0), 0, last, a3k);
            PG8_WAIT_V(8); PG8_WAIT_L(0); PG8_BAR; PG8_MMA(1, 0, At, B0); PG8_MMA(1, 1, At, B1); PG8_BAR; PG8_SCHED;
        }
        if (wr == 0) PG8_BAR;
        PG8_MFMA_PAD();
        E(acc, cur, wr, wc, fr, fq);
        if (!has_next) break;
#pragma unroll
        for (int a = 0; a < 2; ++a)
#pragma unroll
            for (int b = 0; b < 2; ++b)
#pragma unroll
                for (int m = 0; m < 4; ++m)
#pragma unroll
                    for (int n = 0; n < 2; ++n) acc[a][b][m][n] = (f32x4){0.f, 0.f, 0.f, 0.f};
        PG8_MFMA_PAD();
        cur = nxt; cB = nB; cA = nA; ++ui;
        if constexpr (Sched::GATHER) {
#pragma unroll
            for (int h = 0; h < 2; ++h)
#pragma unroll
                for (int i = 0; i < 2; ++i) ca[h][i] = na[h][i]; }
        if (wr == 1) PG8_BAR;
    }
    PG8_WAIT_V(0);
    PG8_BAR;
#undef PG8_SA
#undef PG8_SB
#undef PG8_STAGE_A
#undef PG8_STAGE_B
#undef PG8_LDA
#undef PG8_LDB
#undef PG8_MMA
#undef PG8_WAIT_V
#undef PG8_WAIT_L
#undef PG8_BAR
#undef PG8_SCHED
#undef PG8_MFMA_PAD
}

__device__ __forceinline__ u32x4 pack8(const f32x4& v0, const f32x4& v1) { u32x4 w; w.x = cvt_pk_bf16(v0[0], v0[1]); w.y = cvt_pk_bf16(v0[2], v0[3]); w.z = cvt_pk_bf16(v1[0], v1[1]); w.w = cvt_pk_bf16(v1[2], v1[3]); return w; }

constexpr int EPI_OFF = LDSCTL_OFF + 2048, EPI_WAVE = 16 * 144;
static_assert(EPI_OFF + NWAVES * EPI_WAVE <= LDS_BYTES, "epilogue staging fits");
__device__ __forceinline__ LAS unsigned char* epi_stage(int wv) { extern __shared__ __attribute__((aligned(16))) unsigned char lds_raw[]; return (LAS unsigned char*)lds_raw + EPI_OFF + wv * EPI_WAVE; }
__device__ __forceinline__ void store16x128(bf16* blk, size_t ldc, const u32x4& a, const u32x4& b, int lane, int wv) {
    LAS unsigned char* st = epi_stage(wv);
    const int fq = lane >> 4, fr = lane & 15, r = lane >> 3, p = lane & 7;
    *(LAS u32x4*)(st + fr * 144 + 16 * fq) = a; *(LAS u32x4*)(st + fr * 144 + 64 + 16 * fq) = b;
    const u32x4 s1 = *(const LAS u32x4*)(st + r * 144 + 16 * p), s2 = *(const LAS u32x4*)(st + (r + 8) * 144 + 16 * p);
    bf16* q = blk + (size_t)r * ldc + p * 8;
    *(u32x4*)q = s1; *(u32x4*)(q + 8 * ldc) = s2;
}
__device__ __forceinline__ void store16x64(unsigned char* blk, size_t ldc, const u32x2& a, const u32x2& b, int lane, int wv) {
    LAS unsigned char* st = epi_stage(wv);
    const int fq = lane >> 4, fr = lane & 15, r = lane >> 2, p = lane & 3;
    *(LAS u32x2*)(st + fr * 80 + 8 * fq) = a; *(LAS u32x2*)(st + fr * 80 + 32 + 8 * fq) = b;
    const u32x4 s = *(const LAS u32x4*)(st + r * 80 + 16 * p);
    *(u32x4*)(blk + (size_t)r * ldc + p * 16) = s;
}
struct EpiPlain {
    static constexpr bool MIDHOOK = false; static constexpr int T1 = -1, T2 = -1;
    bf16* O; int ldc; float scale;
    __device__ __forceinline__ void operator()(const Acc& acc, const Unit& u, int wr, int wc, int fr, int fq) const {
        bf16* tile = O + (size_t)(u.pm * BM + wr * 64) * ldc + u.pn * BM + wc * 64;
        const int lane = fq * 16 + fr;
#pragma unroll
        for (int ai = 0; ai < 2; ++ai)
#pragma unroll
            for (int m = 0; m < 4; ++m)
                store16x128(tile + (size_t)(ai * HALF + m * 16) * ldc, (size_t)ldc, pack8(acc[ai][0][m][0] * scale, acc[ai][0][m][1] * scale), pack8(acc[ai][1][m][0] * scale, acc[ai][1][m][1] * scale), lane, wr * 4 + wc);
    }
};
struct EpiPlain8 {
    static constexpr bool MIDHOOK = false; static constexpr int T1 = -1, T2 = -1;
    unsigned char* O; int ldc; float scale;
    __device__ __forceinline__ void operator()(const Acc& acc, const Unit& u, int wr, int wc, int fr, int fq) const {
        unsigned char* tile = O + (size_t)(u.pm * BM + wr * 64) * ldc + u.pn * BM + wc * 64;
        const int lane = fq * 16 + fr;
#pragma unroll
        for (int ai = 0; ai < 2; ++ai)
#pragma unroll
            for (int m = 0; m < 4; ++m) { u32x2 w[2];
#pragma unroll
                for (int bj = 0; bj < 2; ++bj) { const f32x4 v0 = acc[ai][bj][m][0] * scale, v1 = acc[ai][bj][m][1] * scale; w[bj].x = pack4_fp8(v0[0], v0[1], v0[2], v0[3]); w[bj].y = pack4_fp8(v1[0], v1[1], v1[2], v1[3]); }
                store16x64(tile + (size_t)(ai * HALF + m * 16) * ldc, (size_t)ldc, w[0], w[1], lane, wr * 4 + wc); }
    }
};
__device__ __forceinline__ void gate_tile(const Acc& acc, unsigned char* G, const float* bgate, float scale, int row_strip  , int gcol  , int fr, int fq, int wv) {
    unsigned char* tile = G + (size_t)row_strip * GP + gcol;
    const int lane = fq * 16 + fr;
    f32x4 bv[2][2]; const float s2 = -LOG2E * scale;
#pragma unroll
    for (int bj = 0; bj < 2; ++bj)
#pragma unroll
        for (int n = 0; n < 2; ++n) { const f32x4 b_ = *(const f32x4*)(bgate + gcol + bj * 32 + 8 * fq + 4 * n);
#pragma unroll
            for (int j = 0; j < 4; ++j) bv[bj][n][j] = __builtin_amdgcn_exp2f(b_[j] * -LOG2E); }
#pragma unroll
    for (int ai = 0; ai < 2; ++ai)
#pragma unroll
        for (int m = 0; m < 4; ++m) { u32x2 w[2];
#pragma unroll
            for (int bj = 0; bj < 2; ++bj) { unsigned q[8];
#pragma unroll
                for (int n = 0; n < 2; ++n)
#pragma unroll
                    for (int j = 0; j < 4; j += 2) {
                        const f32x2 a2 = {acc[ai][bj][m][n][j], acc[ai][bj][m][n][j + 1]}, b2 = {bv[bj][n][j], bv[bj][n][j + 1]};
                        const f32x2 t2 = a2 * s2;
                        f32x2 d2 = {__builtin_amdgcn_exp2f(t2[0]), __builtin_amdgcn_exp2f(t2[1])}; d2 = d2 * b2 + 1.f;
                        f32x2 g2 = {__builtin_amdgcn_rcpf(d2[0]), __builtin_amdgcn_rcpf(d2[1])}; g2 = g2 * 255.f + 0.5f;
                        const unsigned q0 = (unsigned)g2[0], q1 = (unsigned)g2[1]; q[4 * n + j] = q0 > 1u ? q0 : 1u; q[4 * n + j + 1] = q1 > 1u ? q1 : 1u; }
                w[bj].x = (q[0] | (q[1] << 8)) | ((q[2] | (q[3] << 8)) << 16); w[bj].y = (q[4] | (q[5] << 8)) | ((q[6] | (q[7] << 8)) << 16); }
            store16x64(tile + (size_t)(ai * HALF + m * 16) * GP, (size_t)GP, w[0], w[1], lane, wv); }
}
struct EpiInProj {
    static constexpr bool MIDHOOK = false; static constexpr int T1 = -1, T2 = -1;
    bf16* Z; unsigned char* G; const float* bgate;
    __device__ __forceinline__ void operator()(const Acc& acc, const Unit& u, int wr, int wc, int fr, int fq) const {
        if (u.pn < 20) {
            bf16* tile = Z + (size_t)(u.pm * BM + wr * 64) * ZP + u.pn * BM + wc * 64;
            const int lane = fq * 16 + fr;
#pragma unroll
            for (int ai = 0; ai < 2; ++ai)
#pragma unroll
                for (int m = 0; m < 4; ++m)
                    store16x128(tile + (size_t)(ai * HALF + m * 16) * ZP, (size_t)ZP, pack8(acc[ai][0][m][0], acc[ai][0][m][1]), pack8(acc[ai][1][m][0], acc[ai][1][m][1]), lane, wr * 4 + wc);
        } else gate_tile(acc, G, bgate, 1.f, u.pm * BM + wr * 64, (u.pn - 20) * BM + wc * 64, fr, fq, wr * 4 + wc);
    }
};
struct EpiGates {
    static constexpr bool MIDHOOK = false; static constexpr int T1 = -1, T2 = -1;
    unsigned char* G; const float* bgate; float scale;
    __device__ __forceinline__ void operator()(const Acc& acc, const Unit& u, int wr, int wc, int fr, int fq) const { gate_tile(acc, G, bgate, scale, u.pm * BM + wr * 64, u.pn * BM + wc * 64, fr, fq, wr * 4 + wc); }
};
struct EpiBranch {
    static constexpr bool MIDHOOK = true; static constexpr int T1 = 12, T2 = 20;
    const unsigned char* G; bf16* MG;
    __device__ __forceinline__ void mid(Acc& acc, const Unit& u, int t, int wr, int wc, int fr, int fq) const {
        const int row0 = u.pm * BM + wr * 64 + fr, col0 = u.pn * BM + wc * 64 + 8 * fq, gsel = (t == T1) ? 0 : DM;
        const unsigned char* gbase = G + gsel;
        u32x2 ga[2][4][2], gb[2][4][2];
#pragma unroll
        for (int ai = 0; ai < 2; ++ai)
#pragma unroll
            for (int m = 0; m < 4; ++m)
#pragma unroll
                for (int bj = 0; bj < 2; ++bj) { const unsigned off = (unsigned)(row0 + ai * HALF + m * 16) * (unsigned)GP + (unsigned)(col0 + bj * 32);
                    ga[ai][m][bj] = *(const u32x2*)(gbase + off); gb[ai][m][bj] = *(const u32x2*)(gbase + off + DM); }
#pragma unroll
        for (int ai = 0; ai < 2; ++ai)
#pragma unroll
            for (int m = 0; m < 4; ++m)
#pragma unroll
                for (int bj = 0; bj < 2; ++bj)
#pragma unroll
                    for (int n = 0; n < 2; ++n)
#pragma unroll
                        for (int j = 0; j < 4; ++j) acc[ai][bj][m][n][j] *= ub(ga[ai][m][bj][n], j) * __builtin_amdgcn_rcpf(ub(gb[ai][m][bj][n], j));
    }
    __device__ __forceinline__ void operator()(const Acc& acc, const Unit& u, int wr, int wc, int fr, int fq) const {
        const int row0 = u.pm * BM + wr * 64 + fr, col0 = u.pn * BM + wc * 64 + 8 * fq;
        bf16* tile = MG + (size_t)(u.pm * BM + wr * 64) * DM + u.pn * BM + wc * 64;
        const int lane = fq * 16 + fr;
        u32x2 g2a[2][4][2];
#pragma unroll
        for (int ai = 0; ai < 2; ++ai)
#pragma unroll
            for (int m = 0; m < 4; ++m)
#pragma unroll
                for (int bj = 0; bj < 2; ++bj) g2a[ai][m][bj] = *(const u32x2*)(G + (size_t)(row0 + ai * HALF + m * 16) * GP + 2 * DM + col0 + bj * 32);
#pragma unroll
        for (int ai = 0; ai < 2; ++ai)
#pragma unroll
            for (int m = 0; m < 4; ++m) { u32x4 pk[2];
#pragma unroll
                for (int bj = 0; bj < 2; ++bj) { const u32x2 g2 = g2a[ai][m][bj];
                    f32x4 v0 = acc[ai][bj][m][0], v1 = acc[ai][bj][m][1];
#pragma unroll
                    for (int j = 0; j < 4; ++j) { v0[j] *= ub(g2.x, j) * (1.f / 255.f); v1[j] *= ub(g2.y, j) * (1.f / 255.f); }
                    pk[bj] = pack8(v0, v1); }
                store16x128(tile + (size_t)(ai * HALF + m * 16) * DM, (size_t)DM, pk[0], pk[1], lane, wr * 4 + wc); }
    }
};
struct EpiSwiGLU {
    static constexpr bool MIDHOOK = false; static constexpr int T1 = -1, T2 = -1;
    bf16* U; int ldc;
    __device__ __forceinline__ void operator()(const Acc& acc, const Unit& u, int wr, int wc, int fr, int fq) const {
        const int row0 = u.pm * BM + wr * 64 + fr, col0 = u.pn * HALF + wc * 32 + 8 * fq;
#pragma unroll
        for (int ai = 0; ai < 2; ++ai)
#pragma unroll
            for (int m = 0; m < 4; ++m) { f32x4 v[2];
#pragma unroll
                for (int n = 0; n < 2; ++n)
#pragma unroll
                    for (int j = 0; j < 4; ++j) { const float gt = acc[ai][0][m][n][j], up = acc[ai][1][m][n][j]; v[n][j] = gt * fast_sigmoid(gt) * up; }
                *(u32x4*)(U + (size_t)(row0 + ai * HALF + m * 16) * ldc + col0) = pack8(v[0], v[1]); }
    }
};
struct EpiSwiGLU8 {
    static constexpr bool MIDHOOK = false; static constexpr int T1 = -1, T2 = -1;
    unsigned char* U; int ldc; float ginv, uinv;
    __device__ __forceinline__ void operator()(const Acc& acc, const Unit& u, int wr, int wc, int fr, int fq) const {
        const int lane = fq * 16 + fr; LAS unsigned char* st = epi_stage(wr * 4 + wc);
        const float c2 = -LOG2E * ginv, kinv = 1.f / (ginv * uinv);
        unsigned char* strip = U + (size_t)(u.pm * BM + wr * 64 + (lane >> 1)) * ldc + u.pn * HALF + wc * 32 + 16 * (lane & 1);
#pragma unroll
        for (int ai = 0; ai < 2; ++ai)
#pragma unroll
            for (int mp = 0; mp < 2; ++mp) {
#pragma unroll
                for (int mm = 0; mm < 2; ++mm) { const int m = 2 * mp + mm; float v[8];
#pragma unroll
                    for (int n = 0; n < 2; ++n)
#pragma unroll
                        for (int j = 0; j < 4; j += 2) {
                            const f32x2 ag = {acc[ai][0][m][n][j], acc[ai][0][m][n][j + 1]}, au = {acc[ai][1][m][n][j], acc[ai][1][m][n][j + 1]};
                            const f32x2 t2 = ag * c2; f32x2 e2 = {__builtin_amdgcn_exp2f(t2[0]), __builtin_amdgcn_exp2f(t2[1])}; e2 = e2 * kinv + kinv;
                            const f32x2 r2 = {__builtin_amdgcn_rcpf(e2[0]), __builtin_amdgcn_rcpf(e2[1])}; const f32x2 v2 = (ag * au) * r2; v[4 * n + j] = v2[0]; v[4 * n + j + 1] = v2[1]; }
                    u32x2 w; w.x = pack4_fp8(v[0], v[1], v[2], v[3]); w.y = pack4_fp8(v[4], v[5], v[6], v[7]);
                    *(LAS u32x2*)(st + (fr + 16 * mm) * 48 + 8 * fq) = w; }
                const u32x4 sv = *(const LAS u32x4*)(st + (lane >> 1) * 48 + 16 * (lane & 1));
                *(u32x4*)(strip + (size_t)(ai * HALF + mp * 32) * ldc) = sv; }
    }
};
}

namespace att {
constexpr int AT_NSLOT = 4, AT_K = 0, AT_V = AT_NSLOT * 8192, AT_CS = AT_V + AT_NSLOT * 16384, AT_SCR = AT_CS + 8192;
struct Args {
    const bf16* Z; bf16* O; const float* LF;
    const float* sinks;
    const float* subln;
    float lam, lam_init;
};
__device__ __forceinline__ float swapmax(float v) { auto rr = __builtin_amdgcn_permlane32_swap(__float_as_uint(v), __float_as_uint(v), false, false); return fmaxf(__uint_as_float(rr[0]), __uint_as_float(rr[1])); }
__device__ __forceinline__ float swapsum(float v) { auto rr = __builtin_amdgcn_permlane32_swap(__float_as_uint(v), __float_as_uint(v), false, false); return __uint_as_float(rr[0]) + __uint_as_float(rr[1]); }
__device__ __forceinline__ void glds16(const void* gsrc, unsigned lds_dst) { unsigned keep; const unsigned dst = (unsigned)__builtin_amdgcn_readfirstlane((int)lds_dst);
    asm volatile("s_mov_b32 %0, m0\n\ts_mov_b32 m0, %2\n\ts_nop 0\n\tglobal_load_lds_dwordx4 %1, off\n\ts_mov_b32 m0, %0" : "=&s"(keep) : "v"(gsrc), "s"(dst) : "memory"); }
typedef short v4i16_t __attribute__((ext_vector_type(4)));
__device__ __forceinline__ s16x4 vtr(const LAS unsigned char* p) { return __builtin_bit_cast(s16x4, __builtin_amdgcn_ds_read_tr16_b64_v4i16((LAS v4i16_t*)p)); }

template <int MODE, int NDB>
__device__ __forceinline__ void attn_pass(int tid, f32x16 (&o)[NDB], const bf16* Zb  , LAS unsigned char* lds, int q0, int qcol, int kcol, int vcol, float slope2, float sink2, const float* lfp = nullptr  ) {
    const int lane = tid & 63, r32 = lane & 31, hi = lane >> 5, wid = __builtin_amdgcn_readfirstlane(tid >> 6);
    const int qw = q0 + 32 * wid, tq = qw + r32;
    const int jt_lo = (MODE == 0) ? ((q0 >= 127 ? q0 - 127 : 0) >> 6) : 0, jt_hi = (q0 + 255) >> 6;
    const bf16* kp = Zb + (size_t)lane * ZP + kcol + wid * 8;
    const bf16* vp = Zb + (size_t)(16 * (wid & 3) + (lane >> 2)) * ZP + vcol + (wid >> 2) * 32 + (lane & 3) * 8;
    const unsigned kst = AT_K + wid * 1024, vst = AT_V + wid * 1024;
    const unsigned ldsb = (unsigned)(uintptr_t)lds;
#define ATT_DMA(jj, slot) do { const size_t ro_ = (size_t)((jj) * 64) * ZP; \
        glds16(kp + ro_, ldsb + kst + (slot) * 8192); glds16(vp + ro_, ldsb + vst + (slot) * 16384); \
        if (NDB == 4) glds16(vp + ro_ + 64, ldsb + vst + (slot) * 16384 + 8192); } while (0)
#define ATT_WAIT_BAR(n) do { asm volatile("s_waitcnt vmcnt(" #n ")" ::: "memory"); __builtin_amdgcn_s_waitcnt(0xC07F); __builtin_amdgcn_s_barrier(); asm volatile("" ::: "memory"); } while (0)
    bf16x8 qr[4];
#pragma unroll
    for (int d0 = 0; d0 < 4; ++d0) qr[d0] = *(const bf16x8*)(Zb + (size_t)tq * ZP + qcol + d0 * 16 + hi * 8);
#pragma unroll
    for (int db = 0; db < NDB; ++db) o[db] = f32x16{};
    constexpr float THR = 8.f;
    float mref = 0.f, lrun = 0.f;
    const unsigned kfb = AT_K + hi * 1024 + r32 * 16;
    const unsigned vfb = AT_V + ((lane >> 4) & 1) * 32 + (lane & 3) * 8 + (4 * hi + ((lane & 15) >> 2)) * 64;
#define ATT_ACTIVE(jj) ((64 * (jj) <= qw + 31) && (MODE != 0 || (64 * (jj) + 63 >= qw - 127)))
#define ATT_CSLOAD(P0, P1, jj) do { if (MODE == 2) { const LAS float* cs_ = (const LAS float*)(lds + AT_CS) + 64 * (jj) + 4 * hi; \
            _Pragma("unroll") for (int g4 = 0; g4 < 4; ++g4) { const f32x4 c0 = *(const LAS f32x4*)(cs_ + 8 * g4), c1 = *(const LAS f32x4*)(cs_ + 32 + 8 * g4); \
                _Pragma("unroll") for (int e_ = 0; e_ < 4; ++e_) { P0[4 * g4 + e_] = c0[e_]; P1[4 * g4 + e_] = c1[e_]; } } } } while (0)
#define ATT_CINIT(P0, P1, jj) do { const float nm_ = -mref; \
        if (MODE == 2) { _Pragma("unroll") for (int r = 0; r < 16; ++r) { P0[r] = nm_ - P0[r]; P1[r] = nm_ - P1[r]; } \
        } else { float bv_ = fmaf(slope2, (float)(64 * (jj) + 4 * hi - tq), nm_); const float s5_ = 5.f * slope2;        \
            _Pragma("unroll") for (int r = 0; r < 32; ++r) { if (r) bv_ += ((r & 3) ? slope2 : s5_); if (r < 16) P0[r] = bv_; else P1[r - 16] = bv_; } } } while (0)
#define ATT_QKM(P0, P1) do { _Pragma("unroll") for (int d0 = 0; d0 < 4; ++d0) { \
            P0 = __builtin_amdgcn_mfma_f32_32x32x16_bf16(kf[2 * d0], qr[d0], P0, 0, 0, 0); P1 = __builtin_amdgcn_mfma_f32_32x32x16_bf16(kf[2 * d0 + 1], qr[d0], P1, 0, 0, 0); } } while (0)
#define ATT_EXPS(SC0, SC1) do { _Pragma("unroll") for (int r = 0; r < 16; ++r) { SC0[r] = __builtin_amdgcn_exp2f(SC0[r]); SC1[r] = __builtin_amdgcn_exp2f(SC1[r]); } } while (0)
#define ATT_KLOAD(slot) do { const LAS unsigned char* kb_ = lds + kfb + (slot) * 8192; \
        _Pragma("unroll") for (int d0 = 0; d0 < 4; ++d0) { kf[2 * d0] = *(const LAS bf16x8*)(kb_ + d0 * 2048); kf[2 * d0 + 1] = *(const LAS bf16x8*)(kb_ + d0 * 2048 + 512); } } while (0)
#define ATT_VLOAD(slot, dbp) do { const LAS unsigned char* vb_ = lds + vfb + (slot) * 16384 + (dbp) * 4096; \
        _Pragma("unroll") for (int i_ = 0; i_ < 8; ++i_) { const s16x4 lo = vtr(vb_ + (i_ >> 2) * 4096 + (i_ & 3) * 1024), hh = vtr(vb_ + (i_ >> 2) * 4096 + (i_ & 3) * 1024 + 512); \
            kf[i_] = (bf16x8){lo[0], lo[1], lo[2], lo[3], hh[0], hh[1], hh[2], hh[3]}; } } while (0)
#define ATT_PV(dbp) do { _Pragma("unroll") for (int i_ = 0; i_ < 8; ++i_) o[(dbp) + (i_ >> 2)] = __builtin_amdgcn_mfma_f32_32x32x16_bf16(kf[i_], __builtin_bit_cast(bf16x8, pw[i_ & 3]), o[(dbp) + (i_ >> 2)], 0, 0, 0); } while (0)
    bf16x8 kf[8];
    ATT_DMA(jt_lo, 0); ATT_DMA(jt_lo + 1, 1); ATT_DMA(jt_lo + 2, 2);
    if (MODE == 2) {
        const int n = q0 + 256; float v[4];
#pragma unroll
        for (int c = 0; c < 4; ++c) { const int s_ = 4 * tid + c; v[c] = (s_ < n) ? lfp[(size_t)s_ * 16] * LOG2E : 0.f; }
        v[1] += v[0]; v[2] += v[1]; v[3] += v[2];
        float wtot; const float inc = wave_incl_scan(v[3], lane, wtot);
        LAS float* scr = (LAS float*)(lds + AT_SCR);
        if (lane == 63) scr[wid] = wtot;
        __syncthreads();
        float woff = 0.f;
#pragma unroll
        for (int w = 0; w < 8; ++w) woff += (w < wid) ? scr[w] : 0.f;
        const float ex = inc - v[3] + woff;
        LAS float* cs = (LAS float*)(lds + AT_CS);
        if (4 * tid < n) *(LAS f32x4*)(cs + 4 * tid) = (f32x4){v[0] + ex, v[1] + ex, v[2] + ex, v[3] + ex};
    }
#pragma unroll
    for (int d0 = 0; d0 < 4; ++d0) asm volatile("" : "+v"(qr[d0]));
    if (NDB == 4) ATT_WAIT_BAR(3); else ATT_WAIT_BAR(2);
    f32x16 pa0 = f32x16{}, pa1 = f32x16{}, pb0 = f32x16{}, pb1 = f32x16{};
    if (ATT_ACTIVE(jt_lo)) { ATT_KLOAD(0); ATT_CSLOAD(pa0, pa1, jt_lo); ATT_CINIT(pa0, pa1, jt_lo); ATT_QKM(pa0, pa1); }
    const int rl = r32 - 4 * hi;
#define ATT_ITER(SC0, SC1, SN0, SN1, J) do { const int j = (J); \
        const int buf = (j - jt_lo) & 3; \
        const bool more1 = (j < jt_hi), more3 = (j + 3 <= jt_hi); \
        const bool act = ATT_ACTIVE(j), actn = more1 && ATT_ACTIVE(j + 1); \
        if (actn) ATT_KLOAD((buf + 1) & 3); \
        __builtin_amdgcn_sched_barrier(0); \
        if (act) { \
            const int D0 = qw - 64 * j; \
            if (MODE == 0) { \
                const int kvb = 64 * j + 4 * hi; \
_Pragma("unroll") \
                for (int r = 0; r < 16; ++r) { const int d0 = tq - (kvb + (r & 3) + 8 * (r >> 2)), d1 = d0 - 32; \
                    SC0[r] = ((unsigned)d0 < 128u) ? SC0[r] : -INFINITY; SC1[r] = ((unsigned)d1 < 128u) ? SC1[r] : -INFINITY; } \
            } else if (D0 <= 32) { \
                int rlv = rl; asm volatile("" : "+v"(rlv)); \
                const int t0 = (D0 == 0) ? rlv : 127, t1 = (D0 == 0) ? -1 : rlv; \
_Pragma("unroll") \
                for (int r = 0; r < 16; ++r) { const int cr = (r & 3) + 8 * (r >> 2); SC0[r] = (cr <= t0) ? SC0[r] : -INFINITY; SC1[r] = (cr <= t1) ? SC1[r] : -INFINITY; } \
            } \
            float mx = fmaxf(fmaxf(SC0[0], SC1[0]), SC0[1]); \
_Pragma("unroll") \
            for (int r = 1; r < 16; ++r) mx = fmaxf(fmaxf(mx, SC1[r]), (r < 15) ? SC0[r + 1] : SC1[r]); \
            mx = swapmax(mx); \
            if (__any(mx > THR)) { \
                const float dl = fmaxf(mx, 0.f), f = __builtin_amdgcn_exp2f(-dl); \
                mref += dl; lrun *= f; \
_Pragma("unroll") \
                for (int r = 0; r < 16; ++r) { SC0[r] -= dl; SC1[r] -= dl; } \
_Pragma("unroll") \
                for (int db = 0; db < NDB; ++db) \
_Pragma("unroll") \
                    for (int r = 0; r < 16; ++r) o[db][r] *= f; \
            } \
        } \
        __builtin_amdgcn_sched_barrier(0); \
        if (more3) ATT_DMA(j + 3, (buf + 3) & 3);         \
        if (actn) { ATT_CSLOAD(SN0, SN1, j + 1); ATT_CINIT(SN0, SN1, j + 1); }         \
        __builtin_amdgcn_sched_barrier(0); \
        if (act || actn) { ATT_QKM(SN0, SN1); ATT_EXPS(SC0, SC1);         \
_Pragma("unroll") \
            for (int g_ = 0; g_ < 8; ++g_) { __builtin_amdgcn_sched_group_barrier(0x008, 1, 0); __builtin_amdgcn_sched_group_barrier(0x400, 4, 0); } \
        } \
        __builtin_amdgcn_sched_barrier(0); \
        if (act) { \
            ATT_VLOAD(buf, 0); \
            float rs = SC0[0]; \
_Pragma("unroll") \
            for (int r = 0; r < 16; ++r) { if (r) rs += SC0[r]; rs += SC1[r]; } \
            lrun += rs; \
            u32x4 pw[4]; \
_Pragma("unroll") \
            for (int w = 0; w < 4; ++w) { pw[0][w] = cvt_pk_bf16(SC0[2 * w], SC0[2 * w + 1]); pw[1][w] = cvt_pk_bf16(SC0[8 + 2 * w], SC0[8 + 2 * w + 1]); \
                                          pw[2][w] = cvt_pk_bf16(SC1[2 * w], SC1[2 * w + 1]); pw[3][w] = cvt_pk_bf16(SC1[8 + 2 * w], SC1[8 + 2 * w + 1]); } \
            ATT_PV(0); \
            if (NDB == 4) { ATT_VLOAD(buf, 2); ATT_PV(2); } \
        } \
        if (more3) { if (NDB == 4) ATT_WAIT_BAR(3); else ATT_WAIT_BAR(2); } else ATT_WAIT_BAR(0); \
    } while (0)
    for (int jo = jt_lo;;) {
        ATT_ITER(pa0, pa1, pb0, pb1, jo); if (++jo > jt_hi) break;
        ATT_ITER(pb0, pb1, pa0, pa1, jo); if (++jo > jt_hi) break;
    }
#undef ATT_ITER
#undef ATT_CSLOAD
#undef ATT_CINIT
#undef ATT_QKM
#undef ATT_EXPS
#undef ATT_DMA
#undef ATT_WAIT_BAR
#undef ATT_KLOAD
#undef ATT_VLOAD
#undef ATT_PV
#undef ATT_ACTIVE
    float ltot = swapsum(lrun);
    if (MODE == 0) ltot += __builtin_amdgcn_exp2f(sink2 - mref);
    const float inv = (ltot > 0.f) ? 1.f / ltot : 0.f;
#pragma unroll
    for (int db = 0; db < NDB; ++db)
#pragma unroll
        for (int r = 0; r < 16; ++r) o[db][r] *= inv;
}
__device__ __forceinline__ u32x4 pair_swap(u32x2 a, u32x2 b) {
    const auto r0 = __builtin_amdgcn_permlane32_swap(a.x, b.x, false, false), r1 = __builtin_amdgcn_permlane32_swap(a.y, b.y, false, false);
    return (u32x4){r0[0], r1[0], r0[1], r1[1]}; }
template <int NDB> __device__ __forceinline__ void store_o(const f32x16 (&o)[NDB], bf16* Orow  , int hi) {
#pragma unroll
    for (int db = 0; db < NDB; ++db)
#pragma unroll
        for (int g2 = 0; g2 < 2; ++g2) { u32x2 a, b;
            a.x = cvt_pk_bf16(o[db][8 * g2], o[db][8 * g2 + 1]); a.y = cvt_pk_bf16(o[db][8 * g2 + 2], o[db][8 * g2 + 3]);
            b.x = cvt_pk_bf16(o[db][8 * g2 + 4], o[db][8 * g2 + 5]); b.y = cvt_pk_bf16(o[db][8 * g2 + 6], o[db][8 * g2 + 7]);
            *(u32x4*)(Orow + 32 * db + 16 * g2 + 8 * hi) = pair_swap(a, b); }
}
constexpr int NUNITS = 256 + 768 + 768;
__device__ __forceinline__ void attn_unit(int tid, const Args& A, LAS unsigned char* lds, int idx) {
    asm volatile("" : "+v"(tid));
    const int lane = tid & 63, r32 = lane & 31, hi = lane >> 5, wid = __builtin_amdgcn_readfirstlane(tid >> 6);
    if (idx < 256) {
        const int qb = 7 - idx / 32, b = (idx % 32) / 4, h = idx % 4, q0 = qb * 256;
        const bf16* Zb = A.Z + (size_t)b * SEQ * ZP;
        const float slope2 = exp2f(-2.f * (float)(h + 1)) * LOG2E;
        f32x16 o1[4];
        attn_pass<1, 4>(tid, o1, Zb, lds, q0, 1280 + h * 128, 1792 + h * 128, 2304 + h * 128, slope2, 0.f);
        bf16* Orow = A.O + ((size_t)b * SEQ + q0 + 32 * wid + r32) * DM + 768 + h * 128;
        store_o<4>(o1, Orow, hi);
        attn_pass<1, 4>(tid, o1, Zb, lds, q0, 1280 + h * 128 + 64, 1792 + h * 128 + 64, 2304 + h * 128, slope2, 0.f);
        asm volatile("s_waitcnt vmcnt(0)" ::: "memory");
        float ss = 0.f;
#pragma unroll
        for (int db = 0; db < 4; ++db)
#pragma unroll
            for (int g2 = 0; g2 < 2; ++g2) { const u32x4 q4 = *(const volatile u32x4*)(Orow + 32 * db + 16 * g2 + 8 * hi);
                const u32x4 pk = pair_swap((u32x2){q4.x, q4.y}, (u32x2){q4.z, q4.w});
#pragma unroll
                for (int e = 0; e < 8; ++e) { const unsigned w = (e < 2) ? pk.x : (e < 4) ? pk.y : (e < 6) ? pk.z : pk.w;
                    const float a = ((e & 1) ? bf_hi(w) : bf_lo(w)) - A.lam * o1[db][8 * g2 + e]; o1[db][8 * g2 + e] = a; ss += a * a; } }
        ss = swapsum(ss);
        const float rn = rsqrtf(ss * (1.f / 128.f) + RMS_EPS) ;
        const float post = 1.f - A.lam_init;
#pragma unroll
        for (int db = 0; db < 4; ++db)
#pragma unroll
            for (int g4 = 0; g4 < 4; ++g4) { const f32x4 gn = *(const f32x4*)(A.subln + 32 * db + 8 * g4 + 4 * hi);
#pragma unroll
                for (int e = 0; e < 4; ++e) o1[db][4 * g4 + e] = (o1[db][4 * g4 + e] * rn) * gn[e] * post; }
        store_o<4>(o1, Orow, hi);
    } else if (idx < 1024) {
        const int j = idx - 256, qb = 7 - j / 96, b = (j % 96) / 12, h = j % 12, q0 = qb * 256;
        const bf16* Zb = A.Z + (size_t)b * SEQ * ZP;
        f32x16 o[2];
        attn_pass<2, 2>(tid, o, Zb, lds, q0, 2816 + h * 64, 3584 + h * 64, 4352 + h * 64, 0.f, 0.f, A.LF + (size_t)b * SEQ * 16 + h);
        store_o<2>(o, A.O + ((size_t)b * SEQ + q0 + 32 * wid + r32) * DM + 1280 + h * 64, hi);
    } else {
        const int j = idx - 1024, qb = 7 - j / 96, b = (j % 96) / 12, h = j % 12, q0 = qb * 256, kvh = h / 3;
        const bf16* Zb = A.Z + (size_t)b * SEQ * ZP;
        const float slope2 = exp2f(-8.f * (float)(h + 1) / 12.f) * LOG2E;
        f32x16 o[2];
        attn_pass<0, 2>(tid, o, Zb, lds, q0, h * 64, 768 + kvh * 64, 1024 + kvh * 64, slope2, A.sinks[h] * LOG2E);
        store_o<2>(o, A.O + ((size_t)b * SEQ + q0 + 32 * wid + r32) * DM + h * 64, hi);
    }
}
}

#define XB_TMO      128
#define XB_XCNT(j)  (256  + 64 * (j))
#define XB_XSUB(j)  (1280 + 64 * (j))
#define XB_XGEN(j)  (2304 + 64 * (j))
#define XB_TOP      3328
#define XB_TOPGEN   3392
#define XCD_BAR_WORDS 3456
#define XB_SPIN_CAP (1u << 18)
__device__ __forceinline__ unsigned xb_ld(unsigned* p)              { return __hip_atomic_load(p, __ATOMIC_RELAXED, __HIP_MEMORY_SCOPE_AGENT); }
__device__ __forceinline__ unsigned xb_add(unsigned* p, unsigned v) { return __hip_atomic_fetch_add(p, v, __ATOMIC_RELAXED, __HIP_MEMORY_SCOPE_AGENT); }
__device__ __forceinline__ unsigned xb_xcc_id() { return (unsigned)__builtin_amdgcn_s_getreg((3 << 11) | 20) & 0xFu; }
#define XB_SPIN(cond, bar) do { unsigned _sp = 0; while (cond) { __builtin_amdgcn_s_sleep(1); \
    if ((++_sp & 255u) == 0u) { if (xb_ld(&(bar)[XB_TMO])) break; if (_sp > XB_SPIN_CAP) { atomicAdd(&(bar)[XB_TMO], 1u); break; } } } } while (0)
struct XcdBarrier { unsigned* bar; unsigned x; volatile LAS unsigned* st; };
__device__ __forceinline__ XcdBarrier xcd_barrier_post(unsigned* bar, volatile LAS unsigned* st, bool leader) {
    XcdBarrier b; b.bar = bar; b.x = xb_xcc_id(); b.st = st;
    if (leader) (void)xb_add(&bar[XB_XCNT(b.x)], 1u);
    return b;
}
__device__ __forceinline__ void xcd_barrier_complete(unsigned* bar, unsigned x, unsigned& nloc, unsigned& nx) {
    const unsigned G = gridDim.x * gridDim.y * gridDim.z;
    unsigned sum, cnt, mine, sp = 0u;
    for (;;) {
        sum = 0u; cnt = 0u; mine = 0u;
#pragma unroll
        for (unsigned j = 0; j < 16; ++j) { const unsigned c = xb_ld(&bar[XB_XCNT(j)]); sum += c; cnt += (c > 0u) ? 1u : 0u; mine = (j == x) ? c : mine; }
        if (sum == G) break;
        __builtin_amdgcn_s_sleep(1);
        if ((++sp & 255u) == 0u) { if (xb_ld(&bar[XB_TMO])) break; if (sp > XB_SPIN_CAP) { atomicAdd(&bar[XB_TMO], 1u); break; } }
    }
    nloc = mine > 0u ? mine : 1u; nx = cnt > 0u ? cnt : 1u;
}
__device__ __forceinline__ void xcd_barrier(const XcdBarrier& b, bool leader  ) {
    asm volatile("s_waitcnt vmcnt(0)" ::: "memory");
    __syncthreads();
    if (leader) {
        unsigned* bar = b.bar; asm volatile("" : "+s"(bar));
        __builtin_amdgcn_s_waitcnt(0);
        unsigned nloc = b.st[0], nx = b.st[1];
        if (nloc == 0u) { xcd_barrier_complete(bar, b.x, nloc, nx); b.st[0] = nloc; b.st[1] = nx; }
        const unsigned old = xb_add(&bar[XB_XSUB(b.x)], 1u);
        const unsigned gen = old / nloc;
        if (old + 1u == (gen + 1u) * nloc) {
            __builtin_amdgcn_fence(__ATOMIC_RELEASE, "agent");
            asm volatile("s_waitcnt vmcnt(0)" ::: "memory");
            const unsigned og = xb_add(&bar[XB_TOP], 1u);
            const unsigned tg = og / nx;
            if (og + 1u == (tg + 1u) * nx) xb_add(&bar[XB_TOPGEN], 1u);
            else XB_SPIN(xb_ld(&bar[XB_TOPGEN]) == tg, bar);
            __builtin_amdgcn_fence(__ATOMIC_ACQUIRE, "agent");
            xb_add(&bar[XB_XGEN(b.x)], 1u);
            asm volatile("s_waitcnt vmcnt(0)" ::: "memory");
        } else {
            XB_SPIN(xb_ld(&bar[XB_XGEN(b.x)]) == gen, bar);
            __builtin_amdgcn_fence(__ATOMIC_ACQUIRE, "agent");
            asm volatile("s_waitcnt vmcnt(0)" ::: "memory");
        }
    }
    __syncthreads();
}

__device__ __forceinline__ void tr_item(const float* W, int ldw, int k0, int nsrc0, int nvalid, bf16* WT, int ldk, int kdst0, int rdst0, float scale, LAS float* scr, int lane) {
    const int kr = lane >> 3, nc = (lane & 7) * 4;
#pragma unroll
    for (int i = 0; i < 8; ++i) { f32x4 v = (f32x4){0.f, 0.f, 0.f, 0.f};
        if (nc < nvalid) v = *(const f32x4*)(W + (size_t)(k0 + 8 * i + kr) * ldw + nsrc0 + nc);
        LAS float* s = scr + (8 * i + kr) * 33 + nc; s[0] = v[0] * scale; s[1] = v[1] * scale; s[2] = v[2] * scale; s[3] = v[3] * scale; }
    asm volatile("s_waitcnt lgkmcnt(0)" ::: "memory");
    const int c = lane & 7;
#pragma unroll
    for (int j = 0; j < 4; ++j) { const int n = (lane >> 3) + 8 * j; const LAS float* s = scr + (8 * c) * 33 + n;
        u32x4 o; o.x = cvt_pk_bf16(s[0 * 33], s[1 * 33]); o.y = cvt_pk_bf16(s[2 * 33], s[3 * 33]); o.z = cvt_pk_bf16(s[4 * 33], s[5 * 33]); o.w = cvt_pk_bf16(s[6 * 33], s[7 * 33]);
        *(u32x4*)(WT + (size_t)(rdst0 + n) * ldk + kdst0 + k0 + 8 * c) = o; }
    asm volatile("s_waitcnt lgkmcnt(0)" ::: "memory");
}

__device__ __forceinline__ void tr_item8(const float* W, int ldw, int k0, int nsrc0, unsigned char* WT, int ldk, int rdst0, float scale, LAS float* scr, int lane) {
    const int kr = lane >> 3, nc = (lane & 7) * 4;
#pragma unroll
    for (int i = 0; i < 8; ++i) { const f32x4 v = *(const f32x4*)(W + (size_t)(k0 + 8 * i + kr) * ldw + nsrc0 + nc);
        LAS float* s = scr + (8 * i + kr) * 33 + nc; s[0] = v[0] * scale; s[1] = v[1] * scale; s[2] = v[2] * scale; s[3] = v[3] * scale; }
    asm volatile("s_waitcnt lgkmcnt(0)" ::: "memory");
    const int c = lane & 3;
#pragma unroll
    for (int j = 0; j < 2; ++j) { const int n = (lane >> 2) + 16 * j; const LAS float* s = scr + (16 * c) * 33 + n;
        u32x4 o; o.x = pack4_fp8(s[0 * 33], s[1 * 33], s[2 * 33], s[3 * 33]); o.y = pack4_fp8(s[4 * 33], s[5 * 33], s[6 * 33], s[7 * 33]);
        o.z = pack4_fp8(s[8 * 33], s[9 * 33], s[10 * 33], s[11 * 33]); o.w = pack4_fp8(s[12 * 33], s[13 * 33], s[14 * 33], s[15 * 33]);
        *(u32x4*)(WT + (size_t)(rdst0 + n) * ldk + k0 + 16 * c) = o; }
    asm volatile("s_waitcnt lgkmcnt(0)" ::: "memory");
}

struct Args { const float* in[25]; float* out; unsigned char* ws; int ph_lo, ph_hi; };
static_assert(sizeof(Args) == 25 * 8 + 8 + 8 + 8, "Args has no padding");

struct TrDesc { const float* src; int ldw; unsigned char* dst; int pitch; float scale; int fp8; };
__device__ __forceinline__ TrDesc tr_desc(const float* W, int ldw, int k0, int nsrc0, void* WT, int ldk, int kdst0, int rdst0, float scale, int fp8) {
    TrDesc d; d.src = W + (size_t)k0 * ldw + nsrc0; d.ldw = ldw; d.scale = scale; d.fp8 = fp8;
    d.pitch = fp8 ? ldk : 2 * ldk; d.dst = (unsigned char*)WT + (size_t)rdst0 * d.pitch + (size_t)(kdst0 + k0) * (fp8 ? 1 : 2); return d;
}
__device__ __forceinline__ void tr_load(const TrDesc& d, f32x4 (&v)[8], int lane) {
    const int kr = lane >> 3, nc = (lane & 7) * 4;
#pragma unroll
    for (int i = 0; i < 8; ++i) v[i] = __builtin_nontemporal_load((const f32x4*)(d.src + (size_t)(8 * kr + i) * d.ldw + nc));
}
__device__ __forceinline__ void tr_process(const TrDesc& d, const f32x4 (&v)[8], LAS float* scr, int lane) {
    LAS unsigned char* sb = (LAS unsigned char*)scr;
    const int kr = lane >> 3, nq = lane & 7; const float sc = d.scale;
    if (d.fp8) {
#pragma unroll
        for (int e = 0; e < 4; ++e) { u32x2 w;
            w.x = pack4_fp8(v[0][e] * sc, v[1][e] * sc, v[2][e] * sc, v[3][e] * sc); w.y = pack4_fp8(v[4][e] * sc, v[5][e] * sc, v[6][e] * sc, v[7][e] * sc);
            *(LAS u32x2*)(sb + (8 * e + nq) * 80 + 8 * kr) = w; }
        const int c = lane & 3;
#pragma unroll
        for (int j = 0; j < 2; ++j) { const int n = (lane >> 2) + 16 * j; const u32x4 o = *(const LAS u32x4*)(sb + (((n & 3) << 3) | (n >> 2)) * 80 + 16 * c);
            __builtin_nontemporal_store(o, (u32x4*)(d.dst + (size_t)n * d.pitch + 16 * c)); }
    } else {
#pragma unroll
        for (int e = 0; e < 4; ++e) { u32x4 w;
            w.x = cvt_pk_bf16(v[0][e] * sc, v[1][e] * sc); w.y = cvt_pk_bf16(v[2][e] * sc, v[3][e] * sc); w.z = cvt_pk_bf16(v[4][e] * sc, v[5][e] * sc); w.w = cvt_pk_bf16(v[6][e] * sc, v[7][e] * sc);
            *(LAS u32x4*)(sb + (8 * e + nq) * 144 + 16 * kr) = w; }
        const int c = lane & 7;
#pragma unroll
        for (int j = 0; j < 4; ++j) { const int n = (lane >> 3) + 8 * j; const u32x4 o = *(const LAS u32x4*)(sb + (((n & 3) << 3) | (n >> 2)) * 144 + 16 * c);
            __builtin_nontemporal_store(o, (u32x4*)(d.dst + (size_t)n * d.pitch + 16 * c)); }
    }
    asm volatile("s_waitcnt lgkmcnt(0)" ::: "memory");
}
__device__ __forceinline__ TrDesc p0_item(const Args& P, int it) {
    bf16* ws_win = (bf16*)(P.ws + WS_WIN); bf16* ws_wbr = (bf16*)(P.ws + WS_WBR); bf16* ws_wout = (bf16*)(P.ws + WS_WOUT);
    bf16* ws_wgu = (bf16*)(P.ws + WS_WGU); bf16* ws_wd = (bf16*)(P.ws + WS_WD); unsigned char* ws_egu = P.ws + WS_EGU; unsigned char* ws_ed = P.ws + WS_ED;
    constexpr int I_QKV = 32 * 160, I_GT = 32 * 192, I_BA = 12 * 64, I_BB = 8 * 64, I_BC = 12 * 64, I_WO = 32 * 64;
    constexpr int I_LAYER = I_QKV + I_GT + I_BA + I_BB + I_BC + I_WO;
    constexpr int I_DG = 32 * 176, I_DD = 88 * 64;
    constexpr int I_EG = 32 * 224, I_ED = 112 * 64;
    int r = it;
    if (r < 2 * I_LAYER) {
        const int l = r / I_LAYER; r -= l * I_LAYER;
        const float* w_in = P.in[2] + (size_t)l * DM * DIN_SRC; bf16* win_t = ws_win + (size_t)l * NIN * DM;
        if (r < I_QKV) { const int kb = r / 160, nb = r % 160, n0 = nb * 32;
            const bool isq = (n0 < 768) || (n0 >= 1280 && n0 < 1792) || (n0 >= 2816 && n0 < 3584);
            return tr_desc(w_in, DIN_SRC, kb * 64, n0, win_t, DM, 0, n0, isq ? QSCALE : 1.f, 0); } r -= I_QKV;
        if (r < I_GT) { const int kb = r / 192, nb = r % 192;
            if ((MK_FP8_GATES >> l) & 1) return tr_desc(w_in, DIN_SRC, kb * 64, 5132 + nb * 32, win_t + (size_t)5120 * DM, DM, 0, nb * 32, F8_SWG, 1);
            return tr_desc(w_in, DIN_SRC, kb * 64, 5132 + nb * 32, win_t, DM, 0, 5120 + nb * 32, 1.f, 0); } r -= I_GT;
        bf16* wbr_t = ws_wbr + (size_t)l * DM * DM;
        if (r < I_BA) { const int kb = r / 64, nb = r % 64; return tr_desc(P.in[11] + (size_t)l * 768 * DM, DM, kb * 64, nb * 32, wbr_t, DM, 0, nb * 32, 1.f, 0); } r -= I_BA;
        if (r < I_BB) { const int kb = r / 64, nb = r % 64; return tr_desc(P.in[12] + (size_t)l * 512 * DM, DM, kb * 64, nb * 32, wbr_t, DM, 768, nb * 32, 1.f, 0); } r -= I_BB;
        if (r < I_BC) { const int kb = r / 64, nb = r % 64; return tr_desc(P.in[13] + (size_t)l * 768 * DM, DM, kb * 64, nb * 32, wbr_t, DM, 1280, nb * 32, 1.f, 0); } r -= I_BC;
        { const int kb = r / 64, nb = r % 64; return tr_desc(P.in[14] + (size_t)l * DM * DM, DM, kb * 64, nb * 32, ws_wout + (size_t)l * DM * DM, DM, 0, nb * 32, 1.f, 0); }
    }
    r -= 2 * I_LAYER;
    if (r < 2 * I_DG) { const int up = r / I_DG; r -= up * I_DG; const int kb = r / 176, nb = r % 176, n0 = nb * 32;
        return tr_desc(up ? P.in[19] : P.in[18], DFF, kb * 64, n0, ws_wgu, DM, 0, (n0 >> 7) * 256 + ((n0 >> 5) & 3) * 64 + up * 32, 1.f, 0); } r -= 2 * I_DG;
    if (r < I_DD) { const int kb = r / 64, nb = r % 64; return tr_desc(P.in[20], DM, kb * 64, nb * 32, ws_wd, DFF, 0, nb * 32, MK_FP8_DDOWN ? F8_SWD : 1.f, MK_FP8_DDOWN); } r -= I_DD;
    { const int e = r / (2 * I_EG + I_ED); r -= e * (2 * I_EG + I_ED);
      if (r < 2 * I_EG) { const int up = r / I_EG; r -= up * I_EG; const int kb = r / 224, nb = r % 224, n0 = nb * 32;
          return tr_desc((up ? P.in[23] : P.in[22]) + (size_t)e * DM * DFE, DFE, kb * 64, n0, ws_egu + (size_t)e * 2 * DFE * DM, DM, 0, (n0 >> 7) * 256 + ((n0 >> 5) & 3) * 64 + up * 32, F8_SWU, 1); } r -= 2 * I_EG;
      { const int kb = r / 64, nb = r % 64; return tr_desc(P.in[24] + (size_t)e * DFE * DM, DM, kb * 64, nb * 32, ws_ed + (size_t)e * DM * DFE, DFE, 0, nb * 32, F8_SWD, 1); } }
}
constexpr int NI_BASE = 2 * (32 * 160 + 32 * 192 + 12 * 64 + 8 * 64 + 12 * 64 + 32 * 64) + 2 * 32 * 176 + 88 * 64;
constexpr int NI_MOE = NEXP * (2 * 32 * 224 + 112 * 64);
constexpr int NI_P0 = 32 * 160 + 32 * 192;
constexpr int CONV_ITEMS = 128;
constexpr int CONV_L0_START = NI_P0, CONV_L0_UNITS = 816, CONV_L1_START = CONV_L0_START + CONV_L0_UNITS * CONV_ITEMS, CONV_L1_UNITS = (NI_BASE + NI_MOE - CONV_L1_START) / CONV_ITEMS;
static_assert((NI_BASE - NI_P0) % CONV_ITEMS == 0 && (NI_BASE + NI_MOE - CONV_L1_START) % CONV_ITEMS == 0 && CONV_L1_START > NI_BASE, "conversion units are whole; layer 0 takes all the small matrices");
__device__ __forceinline__ void tr_walk(const Args& P, LAS unsigned char* lds, int first, int step, int end, int wave, int lane) {
    LAS float* scr = (LAS float*)(lds + RING_OFF + wave * 16384);
    if (first >= end) return;
    TrDesc d0 = p0_item(P, first); f32x4 v[8]; tr_load(d0, v, lane);
    for (int it = first; it < end; it += step) {
        const bool has = (it + step < end);
        TrDesc d1 = d0; f32x4 w[8];
        if (has) { d1 = p0_item(P, it + step); tr_load(d1, w, lane); }
        tr_process(d0, v, scr, lane);
        if (has) { d0 = d1;
#pragma unroll
            for (int i = 0; i < 8; ++i) v[i] = w[i]; }
    }
}
__device__ __forceinline__ void p0_prologue(const Args& P, LAS unsigned char* lds, int gw, int NGW, int wave, int lane) { tr_walk(P, lds, gw, NGW, NI_P0, wave, lane); }
__device__ __forceinline__ void conv_unit(const Args& P, LAS unsigned char* lds, int layer, int u, int wave, int lane) {
    const int base = (layer ? CONV_L1_START : CONV_L0_START) + u * CONV_ITEMS;
    tr_walk(P, lds, base + wave, NWAVES, base + CONV_ITEMS, wave, lane);
}

__device__ __forceinline__ void ld_row_f32(const float* p, int lane, f32x4 (&v)[8]) {
#pragma unroll
    for (int j = 0; j < 8; ++j) v[j] = *(const f32x4*)(p + 4 * lane + 256 * j);
}
__device__ __forceinline__ void ld_row_bf16(const bf16* p, int lane, f32x4 (&v)[8]) {
#pragma unroll
    for (int j = 0; j < 8; ++j) { const u32x2 w = *(const u32x2*)(p + 4 * lane + 256 * j); v[j] = (f32x4){bf_lo(w.x), bf_hi(w.x), bf_lo(w.y), bf_hi(w.y)}; }
}
__device__ __forceinline__ void st_row_f32(float* p, int lane, const f32x4 (&v)[8]) {
#pragma unroll
    for (int j = 0; j < 8; ++j) *(f32x4*)(p + 4 * lane + 256 * j) = v[j];
}
__device__ __forceinline__ void st_row_bf16(bf16* p, int lane, const f32x4 (&v)[8]) {
#pragma unroll
    for (int j = 0; j < 8; ++j) { u32x2 w; w.x = cvt_pk_bf16(v[j][0], v[j][1]); w.y = cvt_pk_bf16(v[j][2], v[j][3]); *(u32x2*)(p + 4 * lane + 256 * j) = w; }
}
__device__ __forceinline__ float row_rstd(const f32x4 (&v)[8]) {
    float s = 0.f;
#pragma unroll
    for (int j = 0; j < 8; ++j) s += (v[j][0] * v[j][0] + v[j][1] * v[j][1]) + (v[j][2] * v[j][2] + v[j][3] * v[j][3]);
    return rsqrtf(wave_sum(s) * (1.f / DM) + RMS_EPS);
}
__device__ __forceinline__ void fc_stage(const float* w_in, LAS unsigned char* lds, int tid) {
    LAS float* wl = (LAS float*)lds;
    for (int k = tid; k < DM; k += 512) { const float* p = w_in + (size_t)k * DIN_SRC + 5120; const f32x4 a = *(const f32x4*)p, b = *(const f32x4*)(p + 4), c = *(const f32x4*)(p + 8);
        wl[0 * DM + k] = a[0]; wl[1 * DM + k] = a[1]; wl[2 * DM + k] = a[2]; wl[3 * DM + k] = a[3]; wl[4 * DM + k] = b[0]; wl[5 * DM + k] = b[1]; wl[6 * DM + k] = b[2]; wl[7 * DM + k] = b[3];
        wl[8 * DM + k] = c[0]; wl[9 * DM + k] = c[1]; wl[10 * DM + k] = c[2]; wl[11 * DM + k] = c[3]; }
    __syncthreads();
}
__device__ __forceinline__ void fc_row(const f32x4 (&v)[8], const LAS unsigned char* lds, const float* bforget, float* LFrow, int lane) {
    const LAS float* wl = (const LAS float*)lds; float mine = 0.f;
#pragma unroll
    for (int c = 0; c < 12; ++c) { float s = 0.f;
#pragma unroll
        for (int j = 0; j < 8; ++j) { const f32x4 w = *(const LAS f32x4*)(wl + c * DM + 4 * lane + 256 * j); s += (v[j][0] * w[0] + v[j][1] * w[1]) + (v[j][2] * w[2] + v[j][3] * w[3]); }
        s = wave_sum(s); mine = (lane == c) ? s : mine; }
    if (lane < 12) { const float x = mine + bforget[lane];
        LFrow[lane] = fminf(x, 0.f) - 0.6931471805599453f * __builtin_amdgcn_logf(1.f + __builtin_amdgcn_exp2f(-LOG2E * fabsf(x))); }
}
__device__ __forceinline__ void st_row_fp8(unsigned char* p, int lane, const f32x4 (&v)[8], float s) {
#pragma unroll
    for (int j = 0; j < 8; ++j) *(unsigned*)(p + 4 * lane + 256 * j) = pack4_fp8(v[j][0] * s, v[j][1] * s, v[j][2] * s, v[j][3] * s);
}
__device__ __forceinline__ void rows_norm_only(const float* x, const float* g, bf16* H, unsigned char* H8, const float* w_in, const float* bforget, float* LF, LAS unsigned char* lds, int tid, int gw, int NGW, int lane) {
    fc_stage(w_in, lds, tid);
    f32x4 gv[8]; ld_row_f32(g, lane, gv);
    for (int m = gw; m < T_TOK; m += NGW) { f32x4 v[8]; ld_row_f32(x + (size_t)m * DM, lane, v); const float r = row_rstd(v);
#pragma unroll
        for (int j = 0; j < 8; ++j) v[j] = (v[j] * r) * gv[j];
        st_row_bf16(H + (size_t)m * DM, lane, v);
        if (H8) st_row_fp8(H8 + (size_t)m * DM, lane, v, F8_SH);
        fc_row(v, lds, bforget, LF + (size_t)m * 16, lane); }
}
constexpr int RT_W = 0, RT_CNT = 65536, RT_BASE = 65536 + 64, RT_ROW = 65536 + 128;
template <bool ROUTE, bool XINB>
__device__ __forceinline__ void rows_post_mixer(const void* xin, bf16* xout, const bf16* Mo, const float* g1, const float* g2, bf16* H, const float* w_router,
                                                unsigned* ecnt, int* list, float* tokinfo, LAS unsigned char* lds, int r0, int r1, int tid) {
    const int lane = tid & 63, wave = __builtin_amdgcn_readfirstlane(tid >> 6);
    if (ROUTE) {
        LAS float* wl = (LAS float*)(lds + RT_W);
        for (int k = tid; k < DM; k += 512) { const f32x4 a = *(const f32x4*)(w_router + (size_t)k * 8), b = *(const f32x4*)(w_router + (size_t)k * 8 + 4);
            wl[0 * DM + k] = a[0]; wl[1 * DM + k] = a[1]; wl[2 * DM + k] = a[2]; wl[3 * DM + k] = a[3]; wl[4 * DM + k] = b[0]; wl[5 * DM + k] = b[1]; wl[6 * DM + k] = b[2]; wl[7 * DM + k] = b[3]; }
        if (tid < 8) ((LAS unsigned*)(lds + RT_CNT))[tid] = 0u;
        __syncthreads();
    }
    f32x4 gv1[8], gv2[8]; ld_row_f32(g1, lane, gv1); ld_row_f32(g2, lane, gv2);
    for (int m = r0 + wave; m < r1; m += NWAVES) {
        f32x4 v[8], xv[8]; ld_row_bf16(Mo + (size_t)m * DM, lane, v);
        if (XINB) ld_row_bf16((const bf16*)xin + (size_t)m * DM, lane, xv); else ld_row_f32((const float*)xin + (size_t)m * DM, lane, xv);
        const float r = row_rstd(v);
#pragma unroll
        for (int j = 0; j < 8; ++j) xv[j] = xv[j] + (v[j] * r) * gv1[j];
        st_row_bf16(xout + (size_t)m * DM, lane, xv);
        const float r2 = row_rstd(xv);
#pragma unroll
        for (int j = 0; j < 8; ++j) v[j] = (xv[j] * r2) * gv2[j];
        if (ROUTE) {
#pragma unroll
            for (int j = 0; j < 8; ++j) *(unsigned*)((unsigned char*)H + (size_t)m * DM + 4 * lane + 256 * j) = pack4_fp8(v[j][0] * F8_SH, v[j][1] * F8_SH, v[j][2] * F8_SH, v[j][3] * F8_SH);
        } else st_row_bf16(H + (size_t)m * DM, lane, v);
        if (ROUTE) {
            const LAS float* wl = (const LAS float*)(lds + RT_W);
            float lg[8];
#pragma unroll
            for (int e = 0; e < 8; ++e) { float s = 0.f;
#pragma unroll
                for (int j = 0; j < 8; ++j) { const f32x4 w = *(const LAS f32x4*)(wl + e * DM + 4 * lane + 256 * j); s += (v[j][0] * w[0] + v[j][1] * w[1]) + (v[j][2] * w[2] + v[j][3] * w[3]); }
                lg[e] = wave_sum(s); }
            if (lane == 0) {
                int i1 = 0; float v1 = lg[0];
#pragma unroll
                for (int e = 1; e < 8; ++e) if (lg[e] > v1) { v1 = lg[e]; i1 = e; }
                int i2 = -1; float v2 = -INFINITY;
#pragma unroll
                for (int e = 0; e < 8; ++e) if (e != i1 && (i2 < 0 || lg[e] > v2)) { v2 = lg[e]; i2 = e; }
                const float ex = expf(v2 - v1), w1 = 1.f / (1.f + ex), w2 = ex * w1;
                LAS unsigned* lc = (LAS unsigned*)(lds + RT_CNT);
                const unsigned lp1 = __hip_atomic_fetch_add(&lc[i1], 1u, __ATOMIC_RELAXED, __HIP_MEMORY_SCOPE_WORKGROUP), lp2 = __hip_atomic_fetch_add(&lc[i2], 1u, __ATOMIC_RELAXED, __HIP_MEMORY_SCOPE_WORKGROUP);
                LAS unsigned* rr = (LAS unsigned*)(lds + RT_ROW) + (m - r0) * 8;
                rr[0] = (unsigned)i1; rr[1] = (unsigned)i2; rr[2] = lp1; rr[3] = lp2; rr[4] = __float_as_uint(w1); rr[5] = __float_as_uint(w2);
            }
        }
    }
    if (ROUTE) {
        __syncthreads();
        if (tid < 8) { const unsigned c = ((LAS unsigned*)(lds + RT_CNT))[tid]; ((LAS unsigned*)(lds + RT_BASE))[tid] = c ? __hip_atomic_fetch_add(ecnt + tid, c, __ATOMIC_RELAXED, __HIP_MEMORY_SCOPE_AGENT) : 0u; }
        __syncthreads();
        for (int i = tid; i < r1 - r0; i += 512) { const LAS unsigned* rr = (const LAS unsigned*)(lds + RT_ROW) + i * 8; const LAS unsigned* bs = (const LAS unsigned*)(lds + RT_BASE);
            const unsigned e1 = rr[0], e2 = rr[1], p1 = bs[e1] + rr[2], p2 = bs[e2] + rr[3]; const int tok = r0 + i;
            list[(size_t)e1 * CAP + p1] = tok; list[(size_t)e2 * CAP + p2] = tok;
            f32x4 a, b; a[0] = __uint_as_float(e1); a[1] = __uint_as_float(p1); a[2] = __uint_as_float(e2); a[3] = __uint_as_float(p2); b[0] = __uint_as_float(rr[4]); b[1] = __uint_as_float(rr[5]); b[2] = 0.f; b[3] = 0.f;
            *(f32x4*)(tokinfo + (size_t)tok * 8) = a; *(f32x4*)(tokinfo + (size_t)tok * 8 + 4) = b; }
        __syncthreads();
    }
}
template <bool MOE, bool NEXTH>
__device__ __forceinline__ void rows_post_ffn(bf16* xb, float* xfinal, const bf16* F, const float* tokinfo, const LAS int* tbl, const float* g1, const float* g2, bf16* H, unsigned char* H8, const float* w_in, const float* bforget, float* LF, LAS unsigned char* lds, int tid, int gw, int NGW, int lane, int fmode = 0  , int rtf = 0) {
    if (NEXTH) fc_stage(w_in, lds, tid);
    f32x4 gv1[8], gv2[8]; ld_row_f32(g1, lane, gv1); if (NEXTH) ld_row_f32(g2, lane, gv2);
    for (int m = gw; m < T_TOK; m += NGW) {
        f32x4 v[8], xv[8];
        if (MOE) { const f32x4 a = *(const f32x4*)(tokinfo + (size_t)m * 8); const f32x2 wv = *(const f32x2*)(tokinfo + (size_t)m * 8 + 4);
            const int e1 = (int)__float_as_uint(a[0]), p1 = (int)__float_as_uint(a[1]), e2 = (int)__float_as_uint(a[2]), p2 = (int)__float_as_uint(a[3]);
            const size_t s1 = (size_t)tbl[e1] * 256 + p1, s2 = (size_t)tbl[e2] * 256 + p2;
            if (fmode) { const bool ready = __builtin_amdgcn_readfirstlane((int)(((int)(s1 >> 8) < rtf) && ((int)(s2 >> 8) < rtf))) != 0; if ((fmode == 1) != ready) continue; }
            const unsigned char* Y8 = (const unsigned char*)F; const float w1s = wv[0] * (1.f / F8_SY), w2s = wv[1] * (1.f / F8_SY);
#pragma unroll
            for (int j = 0; j < 8; ++j) { const unsigned a8 = *(const unsigned*)(Y8 + s1 * DM + 4 * lane + 256 * j), b8 = *(const unsigned*)(Y8 + s2 * DM + 4 * lane + 256 * j);
                const f32x2 al = __builtin_amdgcn_cvt_pk_f32_fp8((int)a8, false), ah = __builtin_amdgcn_cvt_pk_f32_fp8((int)a8, true), bl = __builtin_amdgcn_cvt_pk_f32_fp8((int)b8, false), bh = __builtin_amdgcn_cvt_pk_f32_fp8((int)b8, true);
                v[j] = (f32x4){al[0] * w1s + bl[0] * w2s, al[1] * w1s + bl[1] * w2s, ah[0] * w1s + bh[0] * w2s, ah[1] * w1s + bh[1] * w2s}; }
        } else ld_row_bf16(F + (size_t)m * DM, lane, v);
        ld_row_bf16(xb + (size_t)m * DM, lane, xv);
        const float r = row_rstd(v);
#pragma unroll
        for (int j = 0; j < 8; ++j) xv[j] = xv[j] + (v[j] * r) * gv1[j];
        if (NEXTH) st_row_bf16(xb + (size_t)m * DM, lane, xv); else st_row_f32(xfinal + (size_t)m * DM, lane, xv);
        if (NEXTH) { const float r2 = row_rstd(xv);
#pragma unroll
            for (int j = 0; j < 8; ++j) v[j] = (xv[j] * r2) * gv2[j];
            st_row_bf16(H + (size_t)m * DM, lane, v);
            if (H8) st_row_fp8(H8 + (size_t)m * DM, lane, v, F8_SH);
            fc_row(v, lds, bforget, LF + (size_t)m * 16, lane); }
    }
}

constexpr int N_PHASES = 17;
__global__ void __launch_bounds__(NWAVES * 64, 2) mk_fwd(Args args) {
    extern __shared__ __attribute__((aligned(16))) unsigned char lds_raw[];
    LAS unsigned char* lds = (LAS unsigned char*)lds_raw;
    volatile LAS unsigned* MISC = (volatile LAS unsigned*)(lds + MISC_OFF);
    const int wave_s = __builtin_amdgcn_readfirstlane((int)threadIdx.x >> 6);
#define TID_NOW() ({ int z_ = 0; asm volatile("" : "+v"(z_)); wave_s * 64 + (int)__builtin_amdgcn_mbcnt_hi(~0u, __builtin_amdgcn_mbcnt_lo(~0u, (unsigned)z_)); })
    const int G = gridDim.x; const int bx = blockIdx.x; const int vcu = (G % 8 == 0) ? (bx % 8) * (G / 8) + bx / 8 : bx;
    const int NGW = G * NWAVES;
    auto ptid = [wave_s]() __attribute__((always_inline)) { int z_ = 0; asm volatile("" : "+v"(z_)); return wave_s * 64 + (int)__builtin_amdgcn_mbcnt_hi(~0u, __builtin_amdgcn_mbcnt_lo(~0u, (unsigned)z_)); };
    const Args& P = args;
    unsigned* ctl0 = (unsigned*)(P.ws + WS_CTL);
    for (int u = TID_NOW(); u < (LDS_BYTES - LDSCTL_OFF) / 4; u += NWAVES * 64) ((LAS unsigned*)(lds + LDSCTL_OFF))[u] = 0u;
    __syncthreads();
    XcdBarrier bar; bar.bar = ctl0 + CW_BAR; bar.x = 0; bar.st = nullptr;
    if (MK_N_LAUNCHES == 1) bar = xcd_barrier_post(ctl0 + CW_BAR, MISC + 8, TID_NOW() == 0);
#define GRID_BAR() do { if (MK_N_LAUNCHES == 1) xcd_barrier(bar, TID_NOW() == 0); } while (0)
    const int lo = args.ph_lo, hi = args.ph_hi;
#define IN(k) (lo <= (k) && (k) < hi)
#define BOTH(k) (IN(k) && IN((k) + 1))

#define WS_VIEWS() unsigned char* ws_ = P.ws; asm volatile("" : "+s"(ws_)); \
    bf16* H = (bf16*)(ws_ + WS_H); bf16* Z = (bf16*)(ws_ + WS_Z); bf16* Gt = (bf16*)(ws_ + WS_G); bf16* O = (bf16*)(ws_ + WS_O); bf16* MG = (bf16*)(ws_ + WS_MG); \
    bf16* U = (bf16*)(ws_ + WS_U); bf16* Mo = (bf16*)(ws_ + WS_MO); bf16* Y = (bf16*)(ws_ + WS_Y); float* LF = (float*)(ws_ + WS_LF); \
    int* list = (int*)(ws_ + WS_LIST); float* tokinfo = (float*)(ws_ + WS_TOK); unsigned* ctl = (unsigned*)(ws_ + WS_CTL); \
    (void)H; (void)Z; (void)Gt; (void)O; (void)MG; (void)U; (void)Mo; (void)Y; (void)LF; (void)list; (void)tokinfo; (void)ctl
    LAS int* tbl = (LAS int*)(lds + LDSCTL_OFF);

    if (IN(0)) { WS_VIEWS();
        { const int t = ptid(), lane = t & 63, wave = __builtin_amdgcn_readfirstlane(t >> 6), gw = vcu * NWAVES + wave;
          p0_prologue(P, lds, gw, NGW, wave, lane);
          if (MK_PROBE_DUP == 1) { asm volatile("" ::: "memory"); p0_prologue(P, lds, gw, NGW, wave, lane); }
          __syncthreads();
          rows_norm_only(P.in[0], P.in[1], H, (MK_FP8_GATES & 1) ? ws_ + WS_H8 : nullptr, P.in[2], P.in[3], LF, lds, t, gw, NGW, lane); }
        if (BOTH(0)) GRID_BAR();
    }
    for (int layer = 0; layer < 2; ++layer) {
        const int pb = 1 + 8 * layer;
        if (IN(pb + 0)) { WS_VIEWS();
            const bf16* win_t = (const bf16*)(ws_ + WS_WIN) + (size_t)layer * NIN * DM;
            if ((MK_FP8_GATES >> layer) & 1) {
                { pg8::Gemm g{H, win_t, DM}; pg8::StaticOrder S; S.init(T_TOK / 256, 20, G, bx); pg8::EpiPlain E{Z, ZP, 1.f};
                  pg8::gemm_phase(ptid(), lds + RING_OFF, g, S, E); }
                { pg8::Gemm g{(const bf16*)(ws_ + WS_H8), win_t + (size_t)5120 * DM, DM / 2}; pg8::StaticOrder S; S.init(T_TOK / 256, 24, G, bx); pg8::EpiGates E{(unsigned char*)Gt, P.in[4] + (size_t)layer * GP, F8_GT_INV};
                  pg8::gemm_phase<pg8::EpiGates, pg8::StaticOrder, true>(ptid(), lds + RING_OFF, g, S, E); }
            } else {
                pg8::Gemm g{H, win_t, DM}; pg8::StaticOrder S; S.init(T_TOK / 256, 44, G, bx);
                pg8::EpiInProj E{Z, (unsigned char*)Gt, P.in[4] + (size_t)layer * GP};
                pg8::gemm_phase(ptid(), lds + RING_OFF, g, S, E);
            }
            if (BOTH(pb + 0)) GRID_BAR();
        }
        if (IN(pb + 1)) { WS_VIEWS();
            const int t = ptid(), lane = t & 63;
            att::Args A; A.Z = Z; A.O = O; A.LF = LF; A.sinks = P.in[5] + layer * 12; A.subln = P.in[10] + layer * 128;
            { float s1 = P.in[6][layer * 64 + lane] * P.in[7][layer * 64 + lane], s2 = P.in[8][layer * 64 + lane] * P.in[9][layer * 64 + lane];
              s1 = wave_sum(s1); s2 = wave_sum(s2);
              A.lam_init = 0.8f - 0.6f * expf(-0.3f * (float)layer); A.lam = expf(s1) - expf(s2) + A.lam_init; }
            unsigned* qhead = ctl + CW_ATTQ + 64 * layer;
            const unsigned nconv = layer ? (unsigned)CONV_L1_UNITS : (unsigned)CONV_L0_UNITS, NGRP = (nconv + 2u) / 3u, NQ1 = NGRP * 7u, NQ = NQ1 + ((unsigned)att::NUNITS - NGRP * 4u);
            static_assert(((CONV_L0_UNITS + 2) / 3) * 4 <= att::NUNITS && ((CONV_L1_UNITS + 2) / 3) * 4 <= att::NUNITS, "queue interleave");
            unsigned nxt = 0u; if (t == 0) nxt = __hip_atomic_fetch_add(qhead, 1u, __ATOMIC_RELAXED, __HIP_MEMORY_SCOPE_AGENT);
            for (;;) {
                if (t == 0) MISC[0] = nxt;
                __syncthreads();
                unsigned idx = MISC[0];
                __syncthreads();
                if (idx >= NQ * (MK_PROBE_DUP == 2 ? 4u : 1u)) break;
                if (t == 0) nxt = __hip_atomic_fetch_add(qhead, 1u, __ATOMIC_RELAXED, __HIP_MEMORY_SCOPE_AGENT);
                if (MK_PROBE_DUP == 2) idx %= NQ;
                int au = (int)(NGRP * 4u + (idx - NQ1)), cu = -1;
                if (idx < NQ1) { const unsigned grp = idx / 7u, rem = idx - grp * 7u; au = (int)(grp * 4u + rem); if (rem >= 4u) cu = (int)(grp * 3u + (rem - 4u)); }
                if (cu < 0) att::attn_unit(t, A, lds + RING_OFF, au);
                else if ((unsigned)cu < nconv) conv_unit(P, lds, layer, cu, __builtin_amdgcn_readfirstlane(t >> 6), lane);
            }
            if (BOTH(pb + 1)) GRID_BAR();
        }
        if (IN(pb + 2)) { WS_VIEWS();
            pg8::Gemm g{O, (const bf16*)(P.ws + WS_WBR) + (size_t)layer * DM * DM, DM}; pg8::StaticOrder S; S.init(T_TOK / 256, DM / 256, G, bx);
            pg8::EpiBranch E{(const unsigned char*)Gt, MG};
            int nrep = (MK_PROBE_DUP == 6) ? 2 : 1; asm volatile("" : "+s"(nrep));
            for (int rep = 0; rep < nrep; ++rep) pg8::gemm_phase(ptid(), lds + RING_OFF, g, S, E);
            if (BOTH(pb + 2)) GRID_BAR();
        }
        if (IN(pb + 3)) { WS_VIEWS();
            pg8::Gemm g{MG, (const bf16*)(P.ws + WS_WOUT) + (size_t)layer * DM * DM, DM}; pg8::StaticOrder S; S.init(T_TOK / 256, DM / 256, G, bx);
            pg8::EpiPlain E{Mo, DM, 1.f};
            int nrep = (MK_PROBE_DUP == 6) ? 2 : 1; asm volatile("" : "+s"(nrep));
            for (int rep = 0; rep < nrep; ++rep) pg8::gemm_phase(ptid(), lds + RING_OFF, g, S, E);
            if (BOTH(pb + 3)) GRID_BAR();
        }
        if (IN(pb + 4)) { WS_VIEWS();
            const int rpb = (T_TOK + G - 1) / G, r0 = vcu * rpb, r1 = (r0 + rpb < T_TOK) ? r0 + rpb : T_TOK;
            bf16* XB = (bf16*)(ws_ + WS_XB);
            if (layer == 0) rows_post_mixer<false, false>(P.in[0], XB, Mo, P.in[15] + layer * DM, P.in[16] + layer * DM, H, nullptr, nullptr, nullptr, nullptr, lds, r0, r1, ptid());
            else            rows_post_mixer<true, true>(XB, XB, Mo, P.in[15] + layer * DM, P.in[16] + layer * DM, H, P.in[21], ctl + CW_ECNT, list, tokinfo, lds, r0, r1, ptid());
            if (BOTH(pb + 4)) GRID_BAR();
        }
        if (layer == 0) {
            if (IN(pb + 5)) { WS_VIEWS();
                pg8::Gemm g{H, (const bf16*)(P.ws + WS_WGU), DM}; pg8::StaticOrder S; S.init(T_TOK / 256, 2 * DFF / 256, G, bx);
                if (MK_FP8_DDOWN) { pg8::EpiSwiGLU8 E{(unsigned char*)U, DFF, 1.f, F8_SU}; pg8::gemm_phase(ptid(), lds + RING_OFF, g, S, E); }
                else { pg8::EpiSwiGLU E{U, DFF}; pg8::gemm_phase(ptid(), lds + RING_OFF, g, S, E); }
                if (BOTH(pb + 5)) GRID_BAR();
            }
            if (IN(pb + 6)) { WS_VIEWS();
                if (MK_FP8_DDOWN) { pg8::Gemm g{U, (const bf16*)(P.ws + WS_WD), DFF / 2}; pg8::StaticOrder S; S.init(T_TOK / 256, DM / 256, G, bx);
                    pg8::EpiPlain E{Mo, DM, F8_DN_INV}; pg8::gemm_phase<pg8::EpiPlain, pg8::StaticOrder, true>(ptid(), lds + RING_OFF, g, S, E); }
                else { pg8::Gemm g{U, (const bf16*)(P.ws + WS_WD), DFF}; pg8::StaticOrder S; S.init(T_TOK / 256, DM / 256, G, bx);
                    pg8::EpiPlain E{Mo, DM, 1.f}; pg8::gemm_phase(ptid(), lds + RING_OFF, g, S, E); }
                if (BOTH(pb + 6)) GRID_BAR();
            }
            if (IN(pb + 7)) { WS_VIEWS();
                const int t = ptid(), lane = t & 63, gw = vcu * NWAVES + __builtin_amdgcn_readfirstlane(t >> 6);
                rows_post_ffn<false, true>((bf16*)(ws_ + WS_XB), nullptr, Mo, nullptr, tbl, P.in[17] + layer * DM, P.in[1] + (layer + 1) * DM, H, (MK_FP8_GATES & 2) ? ws_ + WS_H8 : nullptr, P.in[2] + (size_t)(layer + 1) * DM * DIN_SRC, P.in[3] + (layer + 1) * 12, LF, lds, t, gw, NGW, lane);
                if (BOTH(pb + 7)) GRID_BAR();
            }
        } else {
            if (IN(pb + 5) || IN(pb + 6) || IN(pb + 7)) { WS_VIEWS();
                if (TID_NOW() == 0) { int ts = 0;
                    for (int e = 0; e < 8; ++e) { const int c = (int)__hip_atomic_load(ctl + CW_ECNT + e, __ATOMIC_RELAXED, __HIP_MEMORY_SCOPE_AGENT); tbl[e] = ts; tbl[16 + e] = c; ts += (c + 255) >> 8; }
                    tbl[8] = ts; }
                __syncthreads();
            }
            if (IN(pb + 5)) { WS_VIEWS();
                pg8::Gemm g{H, (const bf16*)(P.ws + WS_EGU), DM / 2}; pg8::MoeOrder<true> S; S.init(__builtin_amdgcn_readfirstlane(tbl[8]), 2 * DFE / 256, G, bx); S.tbl = tbl; S.list = list;
                pg8::EpiSwiGLU8 E{(unsigned char*)U, DFE, F8_UP_INV, F8_UP_INV * F8_SU};
                int nrep = (MK_PROBE_DUP == 4) ? 2 : 1; asm volatile("" : "+s"(nrep));
                for (int rep = 0; rep < nrep; ++rep) pg8::gemm_phase<pg8::EpiSwiGLU8, pg8::MoeOrder<true>, true>(ptid(), lds + RING_OFF, g, S, E);
                if (BOTH(pb + 5)) GRID_BAR();
            }
            if (IN(pb + 6)) { WS_VIEWS();
                pg8::Gemm g{U, (const bf16*)(P.ws + WS_ED), DFE / 2}; pg8::DownOrder S; S.setup(__builtin_amdgcn_readfirstlane(tbl[8]), DM / 256, G, bx); S.tbl = tbl; S.list = list;
                pg8::EpiPlain8 E{(unsigned char*)Y, DM, F8_DN_INV * F8_SY};
                int npass = 2; asm volatile("" : "+s"(npass));
                for (int pass = 0; pass < npass; ++pass) { S.pass = pass;
                    pg8::gemm_phase<pg8::EpiPlain8, pg8::DownOrder, true>(ptid(), lds + RING_OFF, g, S, E);
                    if (pass == 0 && S.nrem_units > 0) {
                        asm volatile("s_waitcnt vmcnt(0)" ::: "memory"); __syncthreads();
                        if (TID_NOW() == 0) { __builtin_amdgcn_fence(__ATOMIC_RELEASE, "agent"); asm volatile("s_waitcnt vmcnt(0)" ::: "memory");
                            (void)__hip_atomic_fetch_add(ctl + CW_MD, 1u, __ATOMIC_RELAXED, __HIP_MEMORY_SCOPE_AGENT); } } }
                if (S.nrem_units > 0 && bx >= S.nrem_units) {
                    if (TID_NOW() == 0) { unsigned sp = 0, ok = 1u;
                        while (__hip_atomic_load(ctl + CW_MD, __ATOMIC_RELAXED, __HIP_MEMORY_SCOPE_AGENT) < (unsigned)G) { __builtin_amdgcn_s_sleep(2); if (++sp > (1u << 22)) { ok = 0u; break; } }
                        __builtin_amdgcn_fence(__ATOMIC_ACQUIRE, "agent"); MISC[1] = ok; }
                    __syncthreads();
                    if (MISC[1]) { const int t = ptid(), lane = t & 63, nidle = G - S.nrem_units, gw2 = (bx - S.nrem_units) * NWAVES + __builtin_amdgcn_readfirstlane(t >> 6);
                        rows_post_ffn<true, false>((bf16*)(ws_ + WS_XB), P.out, Y, tokinfo, tbl, P.in[17] + layer * DM, nullptr, nullptr, nullptr, nullptr, nullptr, nullptr, lds, t, gw2, nidle * NWAVES, lane, 1, S.nM); }
                    __syncthreads();
                }
                if (BOTH(pb + 6)) GRID_BAR();
            }
            if (IN(pb + 7)) { WS_VIEWS();
                const int t = ptid(), lane = t & 63, gw = vcu * NWAVES + __builtin_amdgcn_readfirstlane(t >> 6);
                const int nMtot = __builtin_amdgcn_readfirstlane(tbl[8]), nfull = (nMtot * (DM / 256)) / G, rtf = nfull * G / (DM / 256);
                rows_post_ffn<true, false>((bf16*)(ws_ + WS_XB), P.out, Y, tokinfo, tbl, P.in[17] + layer * DM, nullptr, nullptr, nullptr, nullptr, nullptr, nullptr, lds, t, gw, NGW, lane, (rtf < nMtot) ? 2 : 0, rtf);
            }
        }
    }
#undef IN
#undef BOTH
#undef GRID_BAR
}

__global__ void dbg_dump(const bf16* buf, int pitch, float* out) {
    const size_t i = (size_t)blockIdx.x * blockDim.x + threadIdx.x; const size_t row = i / DM; const int c = (int)(i % DM);
    float s = 0.f; for (int k = c; k < pitch; k += DM) s += bf_lo((unsigned)buf[row * pitch + k]);
    out[i] = s;
}
#ifndef MK_DUMP
#define MK_DUMP 0
#endif
extern "C" void kernel_launch(void* const* d_in, const int* in_sizes, int n_in, void* d_out, int out_size, void* d_ws, size_t ws_size, hipStream_t stream) {
    static int grid = 0;
    if (grid == 0) {
        if (n_in != 25 || in_sizes[0] != T_TOK * DM || out_size != T_TOK * DM || ws_size < WS_END) { fprintf(stderr, "kernel_launch: unexpected problem shape (n_in %d, in0 %d, out %d, ws %zu < %zu)\n", n_in, n_in > 0 ? in_sizes[0] : -1, out_size, ws_size, (size_t)WS_END); grid = -1; return; }
        int dev = 0, cus = 0, per_cu = 0;
        if (hipGetDevice(&dev) != hipSuccess || hipDeviceGetAttribute(&cus, hipDeviceAttributeMultiprocessorCount, dev) != hipSuccess) { grid = -1; return; }
        if (hipFuncSetAttribute((const void*)mk_fwd, hipFuncAttributeMaxDynamicSharedMemorySize, LDS_BYTES) != hipSuccess) { fprintf(stderr, "kernel_launch: hipFuncSetAttribute failed\n"); grid = -1; return; }
        if (hipOccupancyMaxActiveBlocksPerMultiprocessor(&per_cu, (const void*)mk_fwd, NWAVES * 64, LDS_BYTES) != hipSuccess || per_cu < 1) fprintf(stderr, "kernel_launch: occupancy query reports %d\n", per_cu);
        (void)hipGetLastError();
        grid = cus;
    }
    if (grid < 0) return;
    if (hipMemsetAsync((char*)d_ws + WS_CTL, 0, CTL_ZERO_BYTES, stream) != hipSuccess) return;
    Args a{};
    for (int i = 0; i < 25; ++i) a.in[i] = (const float*)d_in[i];
    a.out = (float*)d_out; a.ws = (unsigned char*)d_ws;
#if MK_N_LAUNCHES == 1
    a.ph_lo = 0; a.ph_hi = (N_PHASES < MK_STOP_PHASE) ? N_PHASES : MK_STOP_PHASE;
    hipLaunchKernelGGL(mk_fwd, dim3(grid), dim3(NWAVES * 64), LDS_BYTES, stream, a);
#else
    for (int p = 0; p < N_PHASES && p < MK_STOP_PHASE; ++p) { a.ph_lo = p; a.ph_hi = p + 1; hipLaunchKernelGGL(mk_fwd, dim3(grid), dim3(NWAVES * 64), LDS_BYTES, stream, a); }
    if (MK_DUMP) { const unsigned char* w = (const unsigned char*)d_ws; const bf16* b = nullptr; int pitch = DM;
        if (MK_DUMP == 1) { b = (const bf16*)(w + WS_Z); pitch = ZP; } if (MK_DUMP == 2) { b = (const bf16*)(w + WS_G); pitch = GP; } if (MK_DUMP == 3) b = (const bf16*)(w + WS_O);
        if (MK_DUMP == 4) b = (const bf16*)(w + WS_MG); if (MK_DUMP == 5) b = (const bf16*)(w + WS_MO); if (MK_DUMP == 6) b = (const bf16*)(w + WS_H);
        hipLaunchKernelGGL(dbg_dump, dim3(T_TOK * DM / 256), dim3(256), 0, stream, b, pitch, (float*)d_out); }
#endif
}
```

```cpp
#include <hip/hip_runtime.h>
#include <cstdio>
#include <cstdint>

#define LAS __attribute__((address_space(3)))
#define GAS __attribute__((address_space(1)))
typedef unsigned short bf16;
typedef short bf16x8 __attribute__((ext_vector_type(8)));
typedef short s16x4 __attribute__((ext_vector_type(4)));
typedef float f32x2 __attribute__((ext_vector_type(2)));
typedef float f32x4 __attribute__((ext_vector_type(4)));
typedef float f32x16 __attribute__((ext_vector_type(16)));
typedef unsigned u32x2 __attribute__((ext_vector_type(2)));
typedef unsigned u32x4 __attribute__((ext_vector_type(4)));

#ifndef MK_STOP_PHASE
#define MK_STOP_PHASE 99
#endif
#ifndef MK_FP8_GATES
#define MK_FP8_GATES 3
#endif
#ifndef MK_FP8_DDOWN
#define MK_FP8_DDOWN 0
#endif
#ifndef MK_FP8_DUP
#define MK_FP8_DUP 1
#endif
#ifndef MK_PROBE_DUP
#define MK_PROBE_DUP 0
#endif
#ifndef MK_N_LAUNCHES
#define MK_N_LAUNCHES 1
#endif

constexpr int T_TOK = 16384, DM = 2048, SEQ = 2048, NBATCH = 8;
constexpr int ZP = 5120;
constexpr int GP = 6144;
constexpr int NIN = 11520;
constexpr int DIN_SRC = 11276;
constexpr int DFF = 5632, DFE = 7168, NEXP = 8;
constexpr int CAP = 16384;
constexpr int SLOT_ROWS = 32768 + 2048;
constexpr float RMS_EPS = 1e-6f;
constexpr float LOG2E = 1.4426950408889634f;
constexpr float QSCALE = 0.125f * LOG2E;

constexpr size_t MiB = 1u << 20;
constexpr size_t WS_CTL = 0, CTL_ZERO_BYTES = 1 * MiB;
constexpr size_t WS_WIN = 1 * MiB;
constexpr size_t WS_WBR = WS_WIN + 90 * MiB;
constexpr size_t WS_WOUT = WS_WBR + 16 * MiB;
constexpr size_t WS_WGU = WS_WOUT + 16 * MiB;
constexpr size_t WS_WD = WS_WGU + 44 * MiB;
constexpr size_t WS_EGU = WS_WD + 22 * MiB;
constexpr size_t WS_ED = WS_EGU + 448 * MiB;
constexpr size_t WS_H = WS_ED + 224 * MiB;
constexpr size_t WS_Z = WS_H + 64 * MiB;
constexpr size_t WS_G = WS_Z + 160 * MiB;
constexpr size_t WS_O = WS_G + 192 * MiB;
constexpr size_t WS_MG = WS_O + 64 * MiB;
constexpr size_t WS_U = WS_Z;
constexpr size_t WS_MO = WS_MG + 64 * MiB;
constexpr size_t WS_Y = WS_MO + 64 * MiB;
constexpr size_t WS_LF = WS_Y + 136 * MiB;
constexpr size_t WS_LIST = WS_LF + 1 * MiB;
constexpr size_t WS_TOK = WS_LIST + 512 * 1024;
constexpr size_t WS_XB = WS_TOK + 512 * 1024;
constexpr size_t WS_H8 = WS_XB + 64 * MiB;
constexpr size_t WS_END = WS_H8 + 32 * MiB;
static_assert((size_t)SLOT_ROWS * DFE * 2 <= 480 * MiB, "MoE hidden fits the overlay");
constexpr int CW_TMO = 0, CW_CODE = 1;
constexpr int CW_BAR = 4096;
constexpr int CW_ATTQ = 8192;
constexpr int CW_ECNT = 8192 + 256;
constexpr int CW_MD = 8192 + 512;

constexpr int RING_OFF = 0, RING_BYTES = 131072;
constexpr int LDSCTL_OFF = RING_BYTES, MISC_OFF = LDSCTL_OFF + 320;
constexpr int LDS_BYTES = 155648;
constexpr int NWAVES = 8;

typedef __bf16 bf16x2_t __attribute__((ext_vector_type(2)));
__device__ __forceinline__ unsigned cvt_pk_bf16(float lo, float hi) { const f32x2 v = {lo, hi}; const bf16x2_t b = __builtin_convertvector(v, bf16x2_t); return __builtin_bit_cast(unsigned, b); }
__device__ __forceinline__ float bf_lo(unsigned w) { return __builtin_bit_cast(float, w << 16); }
__device__ __forceinline__ float bf_hi(unsigned w) { return __builtin_bit_cast(float, w & 0xffff0000u); }
template <int X> __device__ __forceinline__ float swz_xor(float v) { return __int_as_float(__builtin_amdgcn_ds_swizzle(__float_as_int(v), 0x1f | (X << 10))); }
__device__ __forceinline__ float wave_sum(float v) {
    v += swz_xor<1>(v); v += swz_xor<2>(v); v += swz_xor<4>(v); v += swz_xor<8>(v); v += swz_xor<16>(v);
    const auto rr = __builtin_amdgcn_permlane32_swap(__float_as_uint(v), __float_as_uint(v), false, false);
    return __uint_as_float(rr[0]) + __uint_as_float(rr[1]);
}
__device__ __forceinline__ float wave_incl_scan(float v, int lane, float& total) {
    float pre = v, tot = v, t;
    t = swz_xor<1>(tot);  if (lane & 1)  pre += t; tot += t;
    t = swz_xor<2>(tot);  if (lane & 2)  pre += t; tot += t;
    t = swz_xor<4>(tot);  if (lane & 4)  pre += t; tot += t;
    t = swz_xor<8>(tot);  if (lane & 8)  pre += t; tot += t;
    t = swz_xor<16>(tot); if (lane & 16) pre += t; tot += t;
    const auto rr = __builtin_amdgcn_permlane32_swap(__float_as_uint(tot), __float_as_uint(tot), false, false);
    if (lane & 32) pre += __uint_as_float(rr[0]);
    total = __uint_as_float(rr[0]) + __uint_as_float(rr[1]);
    return pre;
}
__device__ __forceinline__ unsigned pack4_fp8(float a, float b, float c, float d) {
    a = fminf(fmaxf(a, -448.f), 448.f); b = fminf(fmaxf(b, -448.f), 448.f); c = fminf(fmaxf(c, -448.f), 448.f); d = fminf(fmaxf(d, -448.f), 448.f);
    int w = 0; w = __builtin_amdgcn_cvt_pk_fp8_f32(a, b, w, false); w = __builtin_amdgcn_cvt_pk_fp8_f32(c, d, w, true); return (unsigned)w; }
constexpr float F8_SWG = 64.f, F8_GT_INV = 1.f / 1024.f;
constexpr float F8_SY = 16.f;
constexpr float F8_SH = 16.f, F8_SWU = 64.f, F8_SU = 8.f, F8_SWD = 128.f, F8_UP_INV = 1.f / 1024.f, F8_DN_INV = 1.f / 1024.f;
typedef int v8i __attribute__((ext_vector_type(8)));
typedef short s16x16 __attribute__((ext_vector_type(16)));
__device__ __forceinline__ v8i cat8(bf16x8 a, bf16x8 b) { const s16x16 c = __builtin_shufflevector(a, b, 0, 1, 2, 3, 4, 5, 6, 7, 8, 9, 10, 11, 12, 13, 14, 15); return __builtin_bit_cast(v8i, c); }
__device__ __forceinline__ bf16x8 lo8(v8i v) { const s16x16 c = __builtin_bit_cast(s16x16, v); return __builtin_shufflevector(c, c, 0, 1, 2, 3, 4, 5, 6, 7); }
__device__ __forceinline__ bf16x8 hi8(v8i v) { const s16x16 c = __builtin_bit_cast(s16x16, v); return __builtin_shufflevector(c, c, 8, 9, 10, 11, 12, 13, 14, 15); }
__device__ __forceinline__ unsigned pack4_u8(float a, float b, float c, float d) {
    const float ta = fmaxf(__builtin_floorf(fmaf(a, 255.f, 0.5f)), 1.f), tb = fmaxf(__builtin_floorf(fmaf(b, 255.f, 0.5f)), 1.f), tc = fmaxf(__builtin_floorf(fmaf(c, 255.f, 0.5f)), 1.f), td = fmaxf(__builtin_floorf(fmaf(d, 255.f, 0.5f)), 1.f);
    return (unsigned)ta | ((unsigned)tb << 8) | ((unsigned)tc << 16) | ((unsigned)td << 24); }
__device__ __forceinline__ float ub(unsigned w, int k) { return (float)((w >> (8 * k)) & 0xffu); }
__device__ __forceinline__ float fast_sigmoid(float v) { return __builtin_amdgcn_rcpf(1.f + __builtin_amdgcn_exp2f(-LOG2E * v)); }

namespace pg8 {
constexpr int BM = 256, BK = 64, HALF = 128, HTB = HALF * BK * 2, STAGE_BYTES = 8 * HTB, NXCD = 8, WGM = 8;
__host__ __device__ __forceinline__ int lds_byte(int r, int c) { const int st = (r >> 4) * 2 + (c >> 5), rr = r & 15, cc = c & 31, ob = rr * 64 + cc * 2; return st * 1024 + (ob ^ (((ob >> 9) & 1) << 5)); }
__host__ __device__ __forceinline__ void stage_rc(int b, int& R, int& C) { const int st = b / 1024, sb = b % 1024, swz = sb ^ (((sb >> 9) & 1) << 5); R = (st >> 1) * 16 + swz / 64; C = (st & 1) * 32 + (swz % 64) / 2; }
__host__ __device__ __forceinline__ int perm32(int rho) { const int n = rho >> 4, i = rho & 15; return 8 * (i >> 2) + 4 * n + (i & 3); }

struct Unit { int pm, pn; };
struct Gemm { const bf16* A; const bf16* Bt; int K; };

struct StaticOrder {
    static constexpr bool GATHER = false;
    int nM, nN, nwg, G, c;
    __device__ __forceinline__ void init(int nM_, int nN_, int G_, int c_) { nM = nM_; nN = nN_; nwg = nM * nN; G = G_; c = c_; }
    __device__ __forceinline__ bool next(int i, Unit& u) const {
        const long L = (long)i * G + c; if (L >= nwg) return false;
        int wgid = (int)L; { const int q = nwg / NXCD, r = nwg % NXCD, xcd = wgid % NXCD, off = wgid / NXCD; wgid = (xcd < r ? xcd * (q + 1) : r * (q + 1) + (xcd - r) * q) + off; }
        const int nig = WGM * nN, gid = wgid / nig, fm = gid * WGM, gsz = (nM - fm) < WGM ? (nM - fm) : WGM;
        u.pm = fm + ((wgid % nig) % gsz); u.pn = (wgid % nig) / gsz; return true;
    }
    __device__ __forceinline__ int btile(const Unit& u) const { return u.pn; }
};
template <bool GATHER_> struct MoeOrder : StaticOrder {
    static constexpr bool GATHER = GATHER_;
    const LAS int* tbl; const int* list;
    __device__ __forceinline__ int expert(int pm) const { int e = 0;
#pragma unroll
        for (int j = 1; j < 8; ++j) e += (pm >= tbl[j]) ? 1 : 0;
        return __builtin_amdgcn_readfirstlane(e); }
    __device__ __forceinline__ int btile(const Unit& u) const { return expert(u.pm) * nN + u.pn; }
};

struct DownOrder : MoeOrder<false> {
    int nfull, nrem, nrem_units, pass;
    __device__ __forceinline__ void setup(int nMtot, int nN_, int G_, int c_) { nfull = (nMtot * nN_) / G_; const int rtf = nfull * G_ / nN_; nrem = nMtot - rtf; nrem_units = nrem * nN_; pass = 0; init(rtf, nN_, G_, c_); }
    __device__ __forceinline__ bool next(int i, Unit& u) const {
        if (pass == 0) { if (i >= nfull) return false; return StaticOrder::next(i, u); }
        if (i > 0 || c >= nrem_units) return false;
        u.pm = nM + c % nrem; u.pn = c / nrem; return true;
    }
};

template <class Sched> __device__ __forceinline__ void a_offsets(const Sched& S, const Unit& u, const int (&RA)[2], const int (&CA)[2], int K, unsigned (&o)[2][2]) {
    if constexpr (Sched::GATHER) {
        const int e = S.expert(u.pm), lb = __builtin_amdgcn_readfirstlane((u.pm - S.tbl[e]) * 256), cnt = __builtin_amdgcn_readfirstlane(S.tbl[16 + e]); const int* lp = S.list + (size_t)e * CAP;
        int tok[2][2];
#pragma unroll
        for (int h = 0; h < 2; ++h)
#pragma unroll
            for (int i = 0; i < 2; ++i) { const int lr = lb + h * HALF + RA[i]; tok[h][i] = (lr < cnt) ? lp[lr] : 0; }
#pragma unroll
        for (int h = 0; h < 2; ++h)
#pragma unroll
            for (int i = 0; i < 2; ++i) o[h][i] = (unsigned)tok[h][i] * (unsigned)(K * 2) + (unsigned)(CA[i] * 2);
    }
}

typedef f32x4 Acc[2][2][4][2];

template <class Epi, class Sched, bool FP8 = false>
__device__ __forceinline__ void gemm_phase(int tid, LAS unsigned char* lds, const Gemm g, const Sched& S, const Epi& E) {
    const int wid = __builtin_amdgcn_readfirstlane(tid >> 6), lane = tid & 63, wr = wid >> 2, wc = wid & 3, fr = lane & 15, fq = lane >> 4;
    const int K = g.K, nt = K / BK;
    unsigned voffB[2], voffA[2]; int RA[2], CA[2];
#pragma unroll
    for (int i = 0; i < 2; ++i) { int R, C; stage_rc(tid * 16 + i * 8192, R, C); const int Rb = (R & ~31) + perm32(R & 31);
        RA[i] = R; CA[i] = C; voffA[i] = (unsigned)(R * K + C) * 2u; voffB[i] = (unsigned)(((R >> 5) * 64 + perm32(R & 31)) * K + C) * 2u; (void)Rb; }
    const size_t kstep = (size_t)(BK * 2);
    const size_t hstep = (size_t)HALF * K * 2;
    const size_t tstep = 2 * hstep;
    const size_t hB = (size_t)32 * K * 2;
    const unsigned ldsw = (unsigned)wid * 1024u;
    const int aoff = lds_byte(wr * 64 + fr, fq * 8), boff = lds_byte(wc * 32 + fr, fq * 8);
#define PG8_SA(b, h) (((b) * 2 + (h)) * HTB)
#define PG8_SB(b, h) ((4 + (b) * 2 + (h)) * HTB)
#define PG8_STAGE_B(bufoff, gbase) do { _Pragma("unroll") for (int _i = 0; _i < 2; ++_i) \
        __builtin_amdgcn_global_load_lds((const unsigned*)((const char*)(gbase) + voffB[_i]), (LAS unsigned*)(lds + (bufoff) + ldsw + _i * 8192), 16, 0, 0); } while (0)
#define PG8_STAGE_A(bufoff, h, NX, kb) do { _Pragma("unroll") for (int _i = 0; _i < 2; ++_i) { const char* _p; \
        if constexpr (Sched::GATHER) _p = Ab + (kb) + ((NX) ? na[h][_i] : ca[h][_i]); else _p = ((NX) ? nA : cA) + (size_t)(h) * hstep + (kb) + voffA[_i]; \
        __builtin_amdgcn_global_load_lds((const unsigned*)_p, (LAS unsigned*)(lds + (bufoff) + ldsw + _i * 8192), 16, 0, 0); } } while (0)
#define PG8_LDA(dst, b, h) do { _Pragma("unroll") for (int m = 0; m < 4; ++m) dst[m] = cat8(*(const LAS bf16x8*)(lds + PG8_SA(b, h) + aoff + m * 2048), *(const LAS bf16x8*)(lds + PG8_SA(b, h) + aoff + m * 2048 + 1024)); } while (0)
#define PG8_LDB(dst, b, h) do { _Pragma("unroll") for (int n = 0; n < 2; ++n) dst[n] = cat8(*(const LAS bf16x8*)(lds + PG8_SB(b, h) + boff + n * 2048), *(const LAS bf16x8*)(lds + PG8_SB(b, h) + boff + n * 2048 + 1024)); } while (0)
#define PG8_MMA(ai, bj, At, Bt) do { __builtin_amdgcn_s_setprio(1); _Pragma("unroll") for (int m = 0; m < 4; ++m) _Pragma("unroll") for (int n = 0; n < 2; ++n) { \
        if constexpr (FP8) asm volatile("v_mfma_scale_f32_16x16x128_f8f6f4 %0, %1, %2, %0, %3, %3 op_sel_hi:[0,0,0]" : "+v"(acc[ai][bj][m][n]) : "v"(Bt[n]), "v"(At[m]), "v"(one_scale)); \
        else { acc[ai][bj][m][n] = __builtin_amdgcn_mfma_f32_16x16x32_bf16(lo8(Bt[n]), lo8(At[m]), acc[ai][bj][m][n], 0, 0, 0); \
               acc[ai][bj][m][n] = __builtin_amdgcn_mfma_f32_16x16x32_bf16(hi8(Bt[n]), hi8(At[m]), acc[ai][bj][m][n], 0, 0, 0); } } \
        __builtin_amdgcn_s_setprio(0); } while (0)
#define PG8_WAIT_V(n) asm volatile("s_waitcnt vmcnt(" #n ")" ::: "memory")
#define PG8_WAIT_L(n) asm volatile("s_waitcnt lgkmcnt(" #n ")" ::: "memory")
#define PG8_BAR __builtin_amdgcn_s_barrier()
#define PG8_SCHED __builtin_amdgcn_sched_barrier(0)
    Unit cur, nxt; int ui = 0;
    if (!S.next(0, cur)) return;
    Acc acc;
#pragma unroll
    for (int a = 0; a < 2; ++a)
#pragma unroll
        for (int b = 0; b < 2; ++b)
#pragma unroll
            for (int m = 0; m < 4; ++m)
#pragma unroll
                for (int n = 0; n < 2; ++n) acc[a][b][m][n] = (f32x4){0.f, 0.f, 0.f, 0.f};
    v8i At[4], B0[2], B1[2];
    int one_scale = 127; asm volatile("" : "+v"(one_scale));
#define PG8_MFMA_PAD() do { if constexpr (FP8) asm volatile("s_nop 15\n\ts_nop 7" ::: "memory"); } while (0)
    unsigned ca[2][2], na[2][2];
    const char* Ab = (const char*)g.A;
    const char* cA = Ab + (size_t)cur.pm * tstep; const char* nA = cA;
    if constexpr (Sched::GATHER) { a_offsets(S, cur, RA, CA, K, ca);
#pragma unroll
        for (int h = 0; h < 2; ++h)
#pragma unroll
            for (int i = 0; i < 2; ++i) na[h][i] = ca[h][i]; }
    const char* cB = (const char*)g.Bt + (size_t)S.btile(cur) * tstep;
    PG8_STAGE_B(PG8_SB(0, 0), cB); PG8_STAGE_B(PG8_SB(0, 1), cB + hB); PG8_STAGE_A(PG8_SA(0, 0), 0, false, (size_t)0); PG8_STAGE_A(PG8_SA(0, 1), 1, false, (size_t)0);
    if (wr == 1) PG8_BAR;
    PG8_WAIT_V(2); PG8_BAR;
    PG8_STAGE_B(PG8_SB(1, 0), cB + kstep); PG8_STAGE_A(PG8_SA(1, 0), 0, false, kstep); PG8_STAGE_B(PG8_SB(1, 1), cB + hB + kstep);
    PG8_WAIT_V(6); PG8_BAR;
    for (;;) {
        const bool has_next = S.next(ui + 1, nxt);
        if constexpr (Sched::GATHER) { if (has_next) a_offsets(S, nxt, RA, CA, K, na); }
        else nA = has_next ? Ab + (size_t)nxt.pm * tstep : cA;
        const char* nB = has_next ? (const char*)g.Bt + (size_t)S.btile(nxt) * tstep : cB;
        for (int t = 0; t < nt; t += 2) {
            const bool last = (t == nt - 2);
            if constexpr (Epi::MIDHOOK) { if (t == Epi::T1 || t == Epi::T2) E.mid(acc, cur, t, wr, wc, fr, fq); }
            const size_t a1k = (size_t)(t + 1) * kstep;
            const size_t a2k = last ? (size_t)0 : (size_t)(t + 2) * kstep, a3k = a2k + kstep;
            const char* b2 = last ? nB : cB + (size_t)(t + 2) * kstep; const char* b3 = b2 + kstep;
            PG8_LDB(B0, 0, 0); PG8_LDB(B1, 0, 1); PG8_SCHED; PG8_LDA(At, 0, 0); PG8_STAGE_A(PG8_SA(1, 1), 1, false, a1k);
            PG8_WAIT_V(8); PG8_WAIT_L(0); PG8_BAR; PG8_MMA(0, 0, At, B0); PG8_MMA(0, 1, At, B1); PG8_BAR; PG8_SCHED;
            PG8_LDA(At, 0, 1); PG8_STAGE_B(PG8_SB(0, 0), b2); PG8_STAGE_B(PG8_SB(0, 1), b2 + hB); PG8_STAGE_A(PG8_SA(0, 0), 0, last, a2k);
            PG8_WAIT_V(8); PG8_WAIT_L(0); PG8_BAR; PG8_MMA(1, 0, At, B0); PG8_MMA(1, 1, At, B1); PG8_BAR; PG8_SCHED;
            PG8_LDB(B0, 1, 0); PG8_LDB(B1, 1, 1); PG8_SCHED; PG8_LDA(At, 1, 0); PG8_STAGE_A(PG8_SA(0, 1), 1, last, a2k);
            PG8_WAIT_V(8); PG8_WAIT_L(0); PG8_BAR; PG8_MMA(0, 0, At, B0); PG8_MMA(0, 1, At, B1); PG8_BAR; PG8_SCHED;
            PG8_LDA(At, 1, 1); PG8_STAGE_B(PG8_SB(1, 0), b3); PG8_STAGE_B(PG8_SB(1, 1), b3 + hB); PG8_STAGE_A(PG8_SA(1, 0), 0, last, a3k);
            PG8_WAIT_V(8); PG8_WAIT_L(0); PG8_BAR; PG8_MMA(1, 0, At, B0); PG8_MMA(1, 1, At, B1); PG8_BAR; PG8_SCHED;
        }
        if (wr == 0) PG8_BAR;
        PG8_MFMA_PAD();
        E(acc, cur, wr, wc, fr, fq);
        if (!has_next) break;
#pragma unroll
        for (int a = 0; a < 2; ++a)
#pragma unroll
            for (int b = 0; b < 2; ++b)
#pragma unroll
                for (int m = 0; m < 4; ++m)
#pragma unroll
                    for (int n = 0; n < 2; ++n) acc[a][b][m][n] = (f32x4){0.f, 0.f, 0.f, 0.f};
        PG8_MFMA_PAD();
        cur = nxt; cB = nB; cA = nA; ++ui;
        if constexpr (Sched::GATHER) {
#pragma unroll
            for (int h = 0; h < 2; ++h)
#pragma unroll
                for (int i = 0; i < 2; ++i) ca[h][i] = na[h][i]; }
        if (wr == 1) PG8_BAR;
    }
    PG8_WAIT_V(0);
    PG8_BAR;
#undef PG8_SA
#undef PG8_SB
#undef PG8_STAGE_A
#undef PG8_STAGE_B
#undef PG8_LDA
#undef PG8_LDB
#undef PG8_MMA
#undef PG8_WAIT_V
#undef PG8_WAIT_L
#undef PG8_BAR
#undef PG8_SCHED
#undef PG8_MFMA_PAD
}

__device__ __forceinline__ u32x4 pack8(const f32x4& v0, const f32x4& v1) { u32x4 w; w.x = cvt_pk_bf16(v0[0], v0[1]); w.y = cvt_pk_bf16(v0[2], v0[3]); w.z = cvt_pk_bf16(v1[0], v1[1]); w.w = cvt_pk_bf16(v1[2], v1[3]); return w; }

constexpr int EPI_OFF = LDSCTL_OFF + 2048, EPI_WAVE = 16 * 144;
static_assert(EPI_OFF + NWAVES * EPI_WAVE <= LDS_BYTES, "epilogue staging fits");
__device__ __forceinline__ LAS unsigned char* epi_stage(int wv) { extern __shared__ __attribute__((aligned(16))) unsigned char lds_raw[]; return (LAS unsigned char*)lds_raw + EPI_OFF + wv * EPI_WAVE; }
__device__ __forceinline__ void store16x128(bf16* blk, size_t ldc, const u32x4& a, const u32x4& b, int lane, int wv) {
    LAS unsigned char* st = epi_stage(wv);
    const int fq = lane >> 4, fr = lane & 15, r = lane >> 3, p = lane & 7;
    *(LAS u32x4*)(st + fr * 144 + 16 * fq) = a; *(LAS u32x4*)(st + fr * 144 + 64 + 16 * fq) = b;
    const u32x4 s1 = *(const LAS u32x4*)(st + r * 144 + 16 * p), s2 = *(const LAS u32x4*)(st + (r + 8) * 144 + 16 * p);
    bf16* q = blk + (size_t)r * ldc + p * 8;
    *(u32x4*)q = s1; *(u32x4*)(q + 8 * ldc) = s2;
}
__device__ __forceinline__ void store16x64(unsigned char* blk, size_t ldc, const u32x2& a, const u32x2& b, int lane, int wv) {
    LAS unsigned char* st = epi_stage(wv);
    const int fq = lane >> 4, fr = lane & 15, r = lane >> 2, p = lane & 3;
    *(LAS u32x2*)(st + fr * 80 + 8 * fq) = a; *(LAS u32x2*)(st + fr * 80 + 32 + 8 * fq) = b;
    const u32x4 s = *(const LAS u32x4*)(st + r * 80 + 16 * p);
    *(u32x4*)(blk + (size_t)r * ldc + p * 16) = s;
}
struct EpiPlain {
    static constexpr bool MIDHOOK = false; static constexpr int T1 = -1, T2 = -1;
    bf16* O; int ldc; float scale;
    __device__ __forceinline__ void operator()(const Acc& acc, const Unit& u, int wr, int wc, int fr, int fq) const {
        bf16* tile = O + (size_t)(u.pm * BM + wr * 64) * ldc + u.pn * BM + wc * 64;
        const int lane = fq * 16 + fr;
#pragma unroll
        for (int ai = 0; ai < 2; ++ai)
#pragma unroll
            for (int m = 0; m < 4; ++m)
                store16x128(tile + (size_t)(ai * HALF + m * 16) * ldc, (size_t)ldc, pack8(acc[ai][0][m][0] * scale, acc[ai][0][m][1] * scale), pack8(acc[ai][1][m][0] * scale, acc[ai][1][m][1] * scale), lane, wr * 4 + wc);
    }
};
struct EpiPlain8 {
    static constexpr bool MIDHOOK = false; static constexpr int T1 = -1, T2 = -1;
    unsigned char* O; int ldc; float scale;
    __device__ __forceinline__ void operator()(const Acc& acc, const Unit& u, int wr, int wc, int fr, int fq) const {
        unsigned char* tile = O + (size_t)(u.pm * BM + wr * 64) * ldc + u.pn * BM + wc * 64;
        const int lane = fq * 16 + fr;
#pragma unroll
        for (int ai = 0; ai < 2; ++ai)
#pragma unroll
            for (int m = 0; m < 4; ++m) { u32x2 w[2];
#pragma unroll
                for (int bj = 0; bj < 2; ++bj) { const f32x4 v0 = acc[ai][bj][m][0] * scale, v1 = acc[ai][bj][m][1] * scale; w[bj].x = pack4_fp8(v0[0], v0[1], v0[2], v0[3]); w[bj].y = pack4_fp8(v1[0], v1[1], v1[2], v1[3]); }
                store16x64(tile + (size_t)(ai * HALF + m * 16) * ldc, (size_t)ldc, w[0], w[1], lane, wr * 4 + wc); }
    }
};
__device__ __forceinline__ void gate_tile(const Acc& acc, unsigned char* G, const float* bgate, float scale, int row_strip  , int gcol  , int fr, int fq, int wv) {
    unsigned char* tile = G + (size_t)row_strip * GP + gcol;
    const int lane = fq * 16 + fr;
    f32x4 bv[2][2]; const float s2 = -LOG2E * scale;
#pragma unroll
    for (int bj = 0; bj < 2; ++bj)
#pragma unroll
        for (int n = 0; n < 2; ++n) { const f32x4 b_ = *(const f32x4*)(bgate + gcol + bj * 32 + 8 * fq + 4 * n);
#pragma unroll
            for (int j = 0; j < 4; ++j) bv[bj][n][j] = __builtin_amdgcn_exp2f(b_[j] * -LOG2E); }
#pragma unroll
    for (int ai = 0; ai < 2; ++ai)
#pragma unroll
        for (int m = 0; m < 4; ++m) { u32x2 w[2];
#pragma unroll
            for (int bj = 0; bj < 2; ++bj) { unsigned q[8];
#pragma unroll
                for (int n = 0; n < 2; ++n)
#pragma unroll
                    for (int j = 0; j < 4; j += 2) {
                        const f32x2 a2 = {acc[ai][bj][m][n][j], acc[ai][bj][m][n][j + 1]}, b2 = {bv[bj][n][j], bv[bj][n][j + 1]};
                        const f32x2 t2 = a2 * s2;
                        f32x2 d2 = {__builtin_amdgcn_exp2f(t2[0]), __builtin_amdgcn_exp2f(t2[1])}; d2 = d2 * b2 + 1.f;
                        f32x2 g2 = {__builtin_amdgcn_rcpf(d2[0]), __builtin_amdgcn_rcpf(d2[1])}; g2 = g2 * 255.f + 0.5f;
                        const unsigned q0 = (unsigned)g2[0], q1 = (unsigned)g2[1]; q[4 * n + j] = q0 > 1u ? q0 : 1u; q[4 * n + j + 1] = q1 > 1u ? q1 : 1u; }
                w[bj].x = (q[0] | (q[1] << 8)) | ((q[2] | (q[3] << 8)) << 16); w[bj].y = (q[4] | (q[5] << 8)) | ((q[6] | (q[7] << 8)) << 16); }
            store16x64(tile + (size_t)(ai * HALF + m * 16) * GP, (size_t)GP, w[0], w[1], lane, wv); }
}
struct EpiInProj {
    static constexpr bool MIDHOOK = false; static constexpr int T1 = -1, T2 = -1;
    bf16* Z; unsigned char* G; const float* bgate;
    __device__ __forceinline__ void operator()(const Acc& acc, const Unit& u, int wr, int wc, int fr, int fq) const {
        if (u.pn < 20) {
            bf16* tile = Z + (size_t)(u.pm * BM + wr * 64) * ZP + u.pn * BM + wc * 64;
            const int lane = fq * 16 + fr;
#pragma unroll
            for (int ai = 0; ai < 2; ++ai)
#pragma unroll
                for (int m = 0; m < 4; ++m)
                    store16x128(tile + (size_t)(ai * HALF + m * 16) * ZP, (size_t)ZP, pack8(acc[ai][0][m][0], acc[ai][0][m][1]), pack8(acc[ai][1][m][0], acc[ai][1][m][1]), lane, wr * 4 + wc);
        } else gate_tile(acc, G, bgate, 1.f, u.pm * BM + wr * 64, (u.pn - 20) * BM + wc * 64, fr, fq, wr * 4 + wc);
    }
};
struct EpiGates {
    static constexpr bool MIDHOOK = false; static constexpr int T1 = -1, T2 = -1;
    unsigned char* G; const float* bgate; float scale;
    __device__ __forceinline__ void operator()(const Acc& acc, const Unit& u, int wr, int wc, int fr, int fq) const { gate_tile(acc, G, bgate, scale, u.pm * BM + wr * 64, u.pn * BM + wc * 64, fr, fq, wr * 4 + wc); }
};
struct EpiBranch {
    static constexpr bool MIDHOOK = true; static constexpr int T1 = 12, T2 = 20;
    const unsigned char* G; bf16* MG;
    __device__ __forceinline__ void mid(Acc& acc, const Unit& u, int t, int wr, int wc, int fr, int fq) const {
        const int row0 = u.pm * BM + wr * 64 + fr, col0 = u.pn * BM + wc * 64 + 8 * fq, gsel = (t == T1) ? 0 : DM;
        const unsigned char* gbase = G + gsel;
        u32x2 ga[2][4][2], gb[2][4][2];
#pragma unroll
        for (int ai = 0; ai < 2; ++ai)
#pragma unroll
            for (int m = 0; m < 4; ++m)
#pragma unroll
                for (int bj = 0; bj < 2; ++bj) { const unsigned off = (unsigned)(row0 + ai * HALF + m * 16) * (unsigned)GP + (unsigned)(col0 + bj * 32);
                    ga[ai][m][bj] = *(const u32x2*)(gbase + off); gb[ai][m][bj] = *(const u32x2*)(gbase + off + DM); }
#pragma unroll
        for (int ai = 0; ai < 2; ++ai)
#pragma unroll
            for (int m = 0; m < 4; ++m)
#pragma unroll
                for (int bj = 0; bj < 2; ++bj)
#pragma unroll
                    for (int n = 0; n < 2; ++n)
#pragma unroll
                        for (int j = 0; j < 4; ++j) acc[ai][bj][m][n][j] *= ub(ga[ai][m][bj][n], j) * __builtin_amdgcn_rcpf(ub(gb[ai][m][bj][n], j));
    }
    __device__ __forceinline__ void operator()(const Acc& acc, const Unit& u, int wr, int wc, int fr, int fq) const {
        const int row0 = u.pm * BM + wr * 64 + fr, col0 = u.pn * BM + wc * 64 + 8 * fq;
        bf16* tile = MG + (size_t)(u.pm * BM + wr * 64) * DM + u.pn * BM + wc * 64;
        const int lane = fq * 16 + fr;
        u32x2 g2a[2][4][2];
#pragma unroll
        for (int ai = 0; ai < 2; ++ai)
#pragma unroll
            for (int m = 0; m < 4; ++m)
#pragma unroll
                for (int bj = 0; bj < 2; ++bj) g2a[ai][m][bj] = *(const u32x2*)(G + (size_t)(row0 + ai * HALF + m * 16) * GP + 2 * DM + col0 + bj * 32);
#pragma unroll
        for (int ai = 0; ai < 2; ++ai)
#pragma unroll
            for (int m = 0; m < 4; ++m) { u32x4 pk[2];
#pragma unroll
                for (int bj = 0; bj < 2; ++bj) { const u32x2 g2 = g2a[ai][m][bj];
                    f32x4 v0 = acc[ai][bj][m][0], v1 = acc[ai][bj][m][1];
#pragma unroll
                    for (int j = 0; j < 4; ++j) { v0[j] *= ub(g2.x, j) * (1.f / 255.f); v1[j] *= ub(g2.y, j) * (1.f / 255.f); }
                    pk[bj] = pack8(v0, v1); }
                store16x128(tile + (size_t)(ai * HALF + m * 16) * DM, (size_t)DM, pk[0], pk[1], lane, wr * 4 + wc); }
    }
};
struct EpiSwiGLU {
    static constexpr bool MIDHOOK = false; static constexpr int T1 = -1, T2 = -1;
    bf16* U; int ldc; float sinv = 1.f;
    __device__ __forceinline__ void operator()(const Acc& acc, const Unit& u, int wr, int wc, int fr, int fq) const {
        const int row0 = u.pm * BM + wr * 64 + fr, col0 = u.pn * HALF + wc * 32 + 8 * fq;
#pragma unroll
        for (int ai = 0; ai < 2; ++ai)
#pragma unroll
            for (int m = 0; m < 4; ++m) { f32x4 v[2];
#pragma unroll
                for (int n = 0; n < 2; ++n)
#pragma unroll
                    for (int j = 0; j < 4; ++j) { const float gt = acc[ai][0][m][n][j] * sinv, up = acc[ai][1][m][n][j] * sinv; v[n][j] = gt * fast_sigmoid(gt) * up; }
                *(u32x4*)(U + (size_t)(row0 + ai * HALF + m * 16) * ldc + col0) = pack8(v[0], v[1]); }
    }
};
struct EpiSwiGLU8 {
    static constexpr bool MIDHOOK = false; static constexpr int T1 = -1, T2 = -1;
    unsigned char* U; int ldc; float ginv, uinv;
    __device__ __forceinline__ void operator()(const Acc& acc, const Unit& u, int wr, int wc, int fr, int fq) const {
        const int lane = fq * 16 + fr; LAS unsigned char* st = epi_stage(wr * 4 + wc);
        const float c2 = -LOG2E * ginv, kinv = 1.f / (ginv * uinv);
        unsigned char* strip = U + (size_t)(u.pm * BM + wr * 64 + (lane >> 1)) * ldc + u.pn * HALF + wc * 32 + 16 * (lane & 1);
#pragma unroll
        for (int ai = 0; ai < 2; ++ai)
#pragma unroll
            for (int mp = 0; mp < 2; ++mp) {
#pragma unroll
                for (int mm = 0; mm < 2; ++mm) { const int m = 2 * mp + mm; float v[8];
#pragma unroll
                    for (int n = 0; n < 2; ++n)
#pragma unroll
                        for (int j = 0; j < 4; j += 2) {
                            const f32x2 ag = {acc[ai][0][m][n][j], acc[ai][0][m][n][j + 1]}, au = {acc[ai][1][m][n][j], acc[ai][1][m][n][j + 1]};
                            const f32x2 t2 = ag * c2; f32x2 e2 = {__builtin_amdgcn_exp2f(t2[0]), __builtin_amdgcn_exp2f(t2[1])}; e2 = e2 * kinv + kinv;
                            const f32x2 r2 = {__builtin_amdgcn_rcpf(e2[0]), __builtin_amdgcn_rcpf(e2[1])}; const f32x2 v2 = (ag * au) * r2; v[4 * n + j] = v2[0]; v[4 * n + j + 1] = v2[1]; }
                    u32x2 w; w.x = pack4_fp8(v[0], v[1], v[2], v[3]); w.y = pack4_fp8(v[4], v[5], v[6], v[7]);
                    *(LAS u32x2*)(st + (fr + 16 * mm) * 48 + 8 * fq) = w; }
                const u32x4 sv = *(const LAS u32x4*)(st + (lane >> 1) * 48 + 16 * (lane & 1));
                *(u32x4*)(strip + (size_t)(ai * HALF + mp * 32) * ldc) = sv; }
    }
};
}

namespace att {
constexpr int AT_NSLOT = 4, AT_K = 0, AT_V = AT_NSLOT * 8192, AT_CS = AT_V + AT_NSLOT * 16384, AT_SCR = AT_CS + 8192;
struct Args {
    const bf16* Z; bf16* O; const float* LF;
    const float* sinks;
    const float* subln;
    float lam, lam_init;
};
__device__ __forceinline__ float swapmax(float v) { auto rr = __builtin_amdgcn_permlane32_swap(__float_as_uint(v), __float_as_uint(v), false, false); return fmaxf(__uint_as_float(rr[0]), __uint_as_float(rr[1])); }
__device__ __forceinline__ float swapsum(float v) { auto rr = __builtin_amdgcn_permlane32_swap(__float_as_uint(v), __float_as_uint(v), false, false); return __uint_as_float(rr[0]) + __uint_as_float(rr[1]); }
__device__ __forceinline__ void glds16(const void* gsrc, unsigned lds_dst) { unsigned keep; const unsigned dst = (unsigned)__builtin_amdgcn_readfirstlane((int)lds_dst);
    asm volatile("s_mov_b32 %0, m0\n\ts_mov_b32 m0, %2\n\ts_nop 0\n\tglobal_load_lds_dwordx4 %1, off\n\ts_mov_b32 m0, %0" : "=&s"(keep) : "v"(gsrc), "s"(dst) : "memory"); }
typedef short v4i16_t __attribute__((ext_vector_type(4)));
__device__ __forceinline__ s16x4 vtr(const LAS unsigned char* p) { return __builtin_bit_cast(s16x4, __builtin_amdgcn_ds_read_tr16_b64_v4i16((LAS v4i16_t*)p)); }

template <int MODE, int NDB>
__device__ __forceinline__ void attn_pass(int tid, f32x16 (&o)[NDB], const bf16* Zb  , LAS unsigned char* lds, int q0, int qcol, int kcol, int vcol, float slope2, float sink2, const float* lfp = nullptr  ) {
    const int lane = tid & 63, r32 = lane & 31, hi = lane >> 5, wid = __builtin_amdgcn_readfirstlane(tid >> 6);
    const int qw = q0 + 32 * wid, tq = qw + r32;
    const int jt_lo = (MODE == 0) ? ((q0 >= 127 ? q0 - 127 : 0) >> 6) : 0, jt_hi = (q0 + 255) >> 6;
    const bf16* kp = Zb + (size_t)lane * ZP + kcol + wid * 8;
    const bf16* vp = Zb + (size_t)(16 * (wid & 3) + (lane >> 2)) * ZP + vcol + (wid >> 2) * 32 + (lane & 3) * 8;
    const unsigned kst = AT_K + wid * 1024, vst = AT_V + wid * 1024;
    const unsigned ldsb = (unsigned)(uintptr_t)lds;
#define ATT_DMA(jj, slot) do { const size_t ro_ = (size_t)((jj) * 64) * ZP; \
        glds16(kp + ro_, ldsb + kst + (slot) * 8192); glds16(vp + ro_, ldsb + vst + (slot) * 16384); \
        if (NDB == 4) glds16(vp + ro_ + 64, ldsb + vst + (slot) * 16384 + 8192); } while (0)
#define ATT_WAIT_BAR(n) do { asm volatile("s_waitcnt vmcnt(" #n ")" ::: "memory"); __builtin_amdgcn_s_waitcnt(0xC07F); __builtin_amdgcn_s_barrier(); asm volatile("" ::: "memory"); } while (0)
    bf16x8 qr[4];
#pragma unroll
    for (int d0 = 0; d0 < 4; ++d0) qr[d0] = *(const bf16x8*)(Zb + (size_t)tq * ZP + qcol + d0 * 16 + hi * 8);
#pragma unroll
    for (int db = 0; db < NDB; ++db) o[db] = f32x16{};
    constexpr float THR = 8.f;
    float mref = 0.f, lrun = 0.f;
    const unsigned kfb = AT_K + hi * 1024 + r32 * 16;
    const unsigned vfb = AT_V + ((lane >> 4) & 1) * 32 + (lane & 3) * 8 + (4 * hi + ((lane & 15) >> 2)) * 64;
#define ATT_ACTIVE(jj) ((64 * (jj) <= qw + 31) && (MODE != 0 || (64 * (jj) + 63 >= qw - 127)))
#define ATT_CSLOAD(P0, P1, jj) do { if (MODE == 2) { const LAS float* cs_ = (const LAS float*)(lds + AT_CS) + 64 * (jj) + 4 * hi; \
            _Pragma("unroll") for (int g4 = 0; g4 < 4; ++g4) { const f32x4 c0 = *(const LAS f32x4*)(cs_ + 8 * g4), c1 = *(const LAS f32x4*)(cs_ + 32 + 8 * g4); \
                _Pragma("unroll") for (int e_ = 0; e_ < 4; ++e_) { P0[4 * g4 + e_] = c0[e_]; P1[4 * g4 + e_] = c1[e_]; } } } } while (0)
#define ATT_CINIT(P0, P1, jj) do { const float nm_ = -mref; \
        if (MODE == 2) { _Pragma("unroll") for (int r = 0; r < 16; ++r) { P0[r] = nm_ - P0[r]; P1[r] = nm_ - P1[r]; } \
        } else { float bv_ = fmaf(slope2, (float)(64 * (jj) + 4 * hi - tq), nm_); const float s5_ = 5.f * slope2;        \
            _Pragma("unroll") for (int r = 0; r < 32; ++r) { if (r) bv_ += ((r & 3) ? slope2 : s5_); if (r < 16) P0[r] = bv_; else P1[r - 16] = bv_; } } } while (0)
#define ATT_QKM(P0, P1) do { _Pragma("unroll") for (int d0 = 0; d0 < 4; ++d0) { \
            P0 = __builtin_amdgcn_mfma_f32_32x32x16_bf16(kf[2 * d0], qr[d0], P0, 0, 0, 0); P1 = __builtin_amdgcn_mfma_f32_32x32x16_bf16(kf[2 * d0 + 1], qr[d0], P1, 0, 0, 0); } } while (0)
#define ATT_EXPS(SC0, SC1) do { _Pragma("unroll") for (int r = 0; r < 16; ++r) { SC0[r] = __builtin_amdgcn_exp2f(SC0[r]); SC1[r] = __builtin_amdgcn_exp2f(SC1[r]); } } while (0)
#define ATT_KLOAD(slot) do { const LAS unsigned char* kb_ = lds + kfb + (slot) * 8192; \
        _Pragma("unroll") for (int d0 = 0; d0 < 4; ++d0) { kf[2 * d0] = *(const LAS bf16x8*)(kb_ + d0 * 2048); kf[2 * d0 + 1] = *(const LAS bf16x8*)(kb_ + d0 * 2048 + 512); } } while (0)
#define ATT_VLOAD(slot, dbp) do { const LAS unsigned char* vb_ = lds + vfb + (slot) * 16384 + (dbp) * 4096; \
        _Pragma("unroll") for (int i_ = 0; i_ < 8; ++i_) { const s16x4 lo = vtr(vb_ + (i_ >> 2) * 4096 + (i_ & 3) * 1024), hh = vtr(vb_ + (i_ >> 2) * 4096 + (i_ & 3) * 1024 + 512); \
            kf[i_] = (bf16x8){lo[0], lo[1], lo[2], lo[3], hh[0], hh[1], hh[2], hh[3]}; } } while (0)
#define ATT_PV(dbp) do { _Pragma("unroll") for (int i_ = 0; i_ < 8; ++i_) o[(dbp) + (i_ >> 2)] = __builtin_amdgcn_mfma_f32_32x32x16_bf16(kf[i_], __builtin_bit_cast(bf16x8, pw[i_ & 3]), o[(dbp) + (i_ >> 2)], 0, 0, 0); } while (0)
    bf16x8 kf[8];
    ATT_DMA(jt_lo, 0); ATT_DMA(jt_lo + 1, 1); ATT_DMA(jt_lo + 2, 2);
    if (MODE == 2) {
        const int n = q0 + 256; float v[4];
#pragma unroll
        for (int c = 0; c < 4; ++c) { const int s_ = 4 * tid + c; v[c] = (s_ < n) ? lfp[(size_t)s_ * 16] * LOG2E : 0.f; }
        v[1] += v[0]; v[2] += v[1]; v[3] += v[2];
        float wtot; const float inc = wave_incl_scan(v[3], lane, wtot);
        LAS float* scr = (LAS float*)(lds + AT_SCR);
        if (lane == 63) scr[wid] = wtot;
        __syncthreads();
        float woff = 0.f;
#pragma unroll
        for (int w = 0; w < 8; ++w) woff += (w < wid) ? scr[w] : 0.f;
        const float ex = inc - v[3] + woff;
        LAS float* cs = (LAS float*)(lds + AT_CS);
        if (4 * tid < n) *(LAS f32x4*)(cs + 4 * tid) = (f32x4){v[0] + ex, v[1] + ex, v[2] + ex, v[3] + ex};
    }
#pragma unroll
    for (int d0 = 0; d0 < 4; ++d0) asm volatile("" : "+v"(qr[d0]));
    if (NDB == 4) ATT_WAIT_BAR(3); else ATT_WAIT_BAR(2);
    f32x16 pa0 = f32x16{}, pa1 = f32x16{}, pb0 = f32x16{}, pb1 = f32x16{};
    if (ATT_ACTIVE(jt_lo)) { ATT_KLOAD(0); ATT_CSLOAD(pa0, pa1, jt_lo); ATT_CINIT(pa0, pa1, jt_lo); ATT_QKM(pa0, pa1); }
    const int rl = r32 - 4 * hi;
#define ATT_ITER(SC0, SC1, SN0, SN1, J) do { const int j = (J); \
        const int buf = (j - jt_lo) & 3; \
        const bool more1 = (j < jt_hi), more3 = (j + 3 <= jt_hi); \
        const bool act = ATT_ACTIVE(j), actn = more1 && ATT_ACTIVE(j + 1); \
        if (actn) ATT_KLOAD((buf + 1) & 3); \
        __builtin_amdgcn_sched_barrier(0); \
        if (act) { \
            const int D0 = qw - 64 * j; \
            if (MODE == 0) { \
                const int kvb = 64 * j + 4 * hi; \
_Pragma("unroll") \
                for (int r = 0; r < 16; ++r) { const int d0 = tq - (kvb + (r & 3) + 8 * (r >> 2)), d1 = d0 - 32; \
                    SC0[r] = ((unsigned)d0 < 128u) ? SC0[r] : -INFINITY; SC1[r] = ((unsigned)d1 < 128u) ? SC1[r] : -INFINITY; } \
            } else if (D0 <= 32) { \
                int rlv = rl; asm volatile("" : "+v"(rlv)); \
                const int t0 = (D0 == 0) ? rlv : 127, t1 = (D0 == 0) ? -1 : rlv; \
_Pragma("unroll") \
                for (int r = 0; r < 16; ++r) { const int cr = (r & 3) + 8 * (r >> 2); SC0[r] = (cr <= t0) ? SC0[r] : -INFINITY; SC1[r] = (cr <= t1) ? SC1[r] : -INFINITY; } \
            } \
            float mx = fmaxf(fmaxf(SC0[0], SC1[0]), SC0[1]); \
_Pragma("unroll") \
            for (int r = 1; r < 16; ++r) mx = fmaxf(fmaxf(mx, SC1[r]), (r < 15) ? SC0[r + 1] : SC1[r]); \
            mx = swapmax(mx); \
            if (__any(mx > THR)) { \
                const float dl = fmaxf(mx, 0.f), f = __builtin_amdgcn_exp2f(-dl); \
                mref += dl; lrun *= f; \
_Pragma("unroll") \
                for (int r = 0; r < 16; ++r) { SC0[r] -= dl; SC1[r] -= dl; } \
_Pragma("unroll") \
                for (int db = 0; db < NDB; ++db) \
_Pragma("unroll") \
                    for (int r = 0; r < 16; ++r) o[db][r] *= f; \
            } \
        } \
        __builtin_amdgcn_sched_barrier(0); \
        if (more3) ATT_DMA(j + 3, (buf + 3) & 3);         \
        if (actn) { ATT_CSLOAD(SN0, SN1, j + 1); ATT_CINIT(SN0, SN1, j + 1); }         \
        __builtin_amdgcn_sched_barrier(0); \
        if (act || actn) { ATT_QKM(SN0, SN1); ATT_EXPS(SC0, SC1);         \
_Pragma("unroll") \
            for (int g_ = 0; g_ < 8; ++g_) { __builtin_amdgcn_sched_group_barrier(0x008, 1, 0); __builtin_amdgcn_sched_group_barrier(0x400, 4, 0); } \
        } \
        __builtin_amdgcn_sched_barrier(0); \
        if (act) { \
            ATT_VLOAD(buf, 0); \
            float rs = SC0[0]; \
_Pragma("unroll") \
            for (int r = 0; r < 16; ++r) { if (r) rs += SC0[r]; rs += SC1[r]; } \
            lrun += rs; \
            u32x4 pw[4]; \
_Pragma("unroll") \
            for (int w = 0; w < 4; ++w) { pw[0][w] = cvt_pk_bf16(SC0[2 * w], SC0[2 * w + 1]); pw[1][w] = cvt_pk_bf16(SC0[8 + 2 * w], SC0[8 + 2 * w + 1]); \
                                          pw[2][w] = cvt_pk_bf16(SC1[2 * w], SC1[2 * w + 1]); pw[3][w] = cvt_pk_bf16(SC1[8 + 2 * w], SC1[8 + 2 * w + 1]); } \
            ATT_PV(0); \
            if (NDB == 4) { ATT_VLOAD(buf, 2); ATT_PV(2); } \
        } \
        if (more3) { if (NDB == 4) ATT_WAIT_BAR(3); else ATT_WAIT_BAR(2); } else ATT_WAIT_BAR(0); \
    } while (0)
    for (int jo = jt_lo;;) {
        ATT_ITER(pa0, pa1, pb0, pb1, jo); if (++jo > jt_hi) break;
        ATT_ITER(pb0, pb1, pa0, pa1, jo); if (++jo > jt_hi) break;
    }
#undef ATT_ITER
#undef ATT_CSLOAD
#undef ATT_CINIT
#undef ATT_QKM
#undef ATT_EXPS
#undef ATT_DMA
#undef ATT_WAIT_BAR
#undef ATT_KLOAD
#undef ATT_VLOAD
#undef ATT_PV
#undef ATT_ACTIVE
    float ltot = swapsum(lrun);
    if (MODE == 0) ltot += __builtin_amdgcn_exp2f(sink2 - mref);
    const float inv = (ltot > 0.f) ? 1.f / ltot : 0.f;
#pragma unroll
    for (int db = 0; db < NDB; ++db)
#pragma unroll
        for (int r = 0; r < 16; ++r) o[db][r] *= inv;
}
__device__ __forceinline__ u32x4 pair_swap(u32x2 a, u32x2 b) {
    const auto r0 = __builtin_amdgcn_permlane32_swap(a.x, b.x, false, false), r1 = __builtin_amdgcn_permlane32_swap(a.y, b.y, false, false);
    return (u32x4){r0[0], r1[0], r0[1], r1[1]}; }
template <int NDB> __device__ __forceinline__ void store_o(const f32x16 (&o)[NDB], bf16* Orow  , int hi) {
#pragma unroll
    for (int db = 0; db < NDB; ++db)
#pragma unroll
        for (int g2 = 0; g2 < 2; ++g2) { u32x2 a, b;
            a.x = cvt_pk_bf16(o[db][8 * g2], o[db][8 * g2 + 1]); a.y = cvt_pk_bf16(o[db][8 * g2 + 2], o[db][8 * g2 + 3]);
            b.x = cvt_pk_bf16(o[db][8 * g2 + 4], o[db][8 * g2 + 5]); b.y = cvt_pk_bf16(o[db][8 * g2 + 6], o[db][8 * g2 + 7]);
            *(u32x4*)(Orow + 32 * db + 16 * g2 + 8 * hi) = pair_swap(a, b); }
}
constexpr int NUNITS = 256 + 768 + 768;
__device__ __forceinline__ void attn_unit(int tid, const Args& A, LAS unsigned char* lds, int idx) {
    asm volatile("" : "+v"(tid));
    const int lane = tid & 63, r32 = lane & 31, hi = lane >> 5, wid = __builtin_amdgcn_readfirstlane(tid >> 6);
    if (idx < 256) {
        const int qb = 7 - idx / 32, b = (idx % 32) / 4, h = idx % 4, q0 = qb * 256;
        const bf16* Zb = A.Z + (size_t)b * SEQ * ZP;
        const float slope2 = exp2f(-2.f * (float)(h + 1)) * LOG2E;
        f32x16 o1[4];
        attn_pass<1, 4>(tid, o1, Zb, lds, q0, 1280 + h * 128, 1792 + h * 128, 2304 + h * 128, slope2, 0.f);
        bf16* Orow = A.O + ((size_t)b * SEQ + q0 + 32 * wid + r32) * DM + 768 + h * 128;
        store_o<4>(o1, Orow, hi);
        attn_pass<1, 4>(tid, o1, Zb, lds, q0, 1280 + h * 128 + 64, 1792 + h * 128 + 64, 2304 + h * 128, slope2, 0.f);
        asm volatile("s_waitcnt vmcnt(0)" ::: "memory");
        float ss = 0.f;
#pragma unroll
        for (int db = 0; db < 4; ++db)
#pragma unroll
            for (int g2 = 0; g2 < 2; ++g2) { const u32x4 q4 = *(const volatile u32x4*)(Orow + 32 * db + 16 * g2 + 8 * hi);
                const u32x4 pk = pair_swap((u32x2){q4.x, q4.y}, (u32x2){q4.z, q4.w});
#pragma unroll
                for (int e = 0; e < 8; ++e) { const unsigned w = (e < 2) ? pk.x : (e < 4) ? pk.y : (e < 6) ? pk.z : pk.w;
                    const float a = ((e & 1) ? bf_hi(w) : bf_lo(w)) - A.lam * o1[db][8 * g2 + e]; o1[db][8 * g2 + e] = a; ss += a * a; } }
        ss = swapsum(ss);
        const float rn = rsqrtf(ss * (1.f / 128.f) + RMS_EPS) ;
        const float post = 1.f - A.lam_init;
#pragma unroll
        for (int db = 0; db < 4; ++db)
#pragma unroll
            for (int g4 = 0; g4 < 4; ++g4) { const f32x4 gn = *(const f32x4*)(A.subln + 32 * db + 8 * g4 + 4 * hi);
#pragma unroll
                for (int e = 0; e < 4; ++e) o1[db][4 * g4 + e] = (o1[db][4 * g4 + e] * rn) * gn[e] * post; }
        store_o<4>(o1, Orow, hi);
    } else if (idx < 1024) {
        const int j = idx - 256, qb = 7 - j / 96, b = (j % 96) / 12, h = j % 12, q0 = qb * 256;
        const bf16* Zb = A.Z + (size_t)b * SEQ * ZP;
        f32x16 o[2];
        attn_pass<2, 2>(tid, o, Zb, lds, q0, 2816 + h * 64, 3584 + h * 64, 4352 + h * 64, 0.f, 0.f, A.LF + (size_t)b * SEQ * 16 + h);
        store_o<2>(o, A.O + ((size_t)b * SEQ + q0 + 32 * wid + r32) * DM + 1280 + h * 64, hi);
    } else {
        const int j = idx - 1024, qb = 7 - j / 96, b = (j % 96) / 12, h = j % 12, q0 = qb * 256, kvh = h / 3;
        const bf16* Zb = A.Z + (size_t)b * SEQ * ZP;
        const float slope2 = exp2f(-8.f * (float)(h + 1) / 12.f) * LOG2E;
        f32x16 o[2];
        attn_pass<0, 2>(tid, o, Zb, lds, q0, h * 64, 768 + kvh * 64, 1024 + kvh * 64, slope2, A.sinks[h] * LOG2E);
        store_o<2>(o, A.O + ((size_t)b * SEQ + q0 + 32 * wid + r32) * DM + h * 64, hi);
    }
}
}

#define XB_TMO      128
#define XB_XCNT(j)  (256  + 64 * (j))
#define XB_XSUB(j)  (1280 + 64 * (j))
#define XB_XGEN(j)  (2304 + 64 * (j))
#define XB_TOP      3328
#define XB_TOPGEN   3392
#define XCD_BAR_WORDS 3456
#define XB_SPIN_CAP (1u << 18)
__device__ __forceinline__ unsigned xb_ld(unsigned* p)              { return __hip_atomic_load(p, __ATOMIC_RELAXED, __HIP_MEMORY_SCOPE_AGENT); }
__device__ __forceinline__ unsigned xb_add(unsigned* p, unsigned v) { return __hip_atomic_fetch_add(p, v, __ATOMIC_RELAXED, __HIP_MEMORY_SCOPE_AGENT); }
__device__ __forceinline__ unsigned xb_xcc_id() { return (unsigned)__builtin_amdgcn_s_getreg((3 << 11) | 20) & 0xFu; }
#define XB_SPIN(cond, bar) do { unsigned _sp = 0; while (cond) { __builtin_amdgcn_s_sleep(1); \
    if ((++_sp & 255u) == 0u) { if (xb_ld(&(bar)[XB_TMO])) break; if (_sp > XB_SPIN_CAP) { atomicAdd(&(bar)[XB_TMO], 1u); break; } } } } while (0)
struct XcdBarrier { unsigned* bar; unsigned x; volatile LAS unsigned* st; };
__device__ __forceinline__ XcdBarrier xcd_barrier_post(unsigned* bar, volatile LAS unsigned* st, bool leader) {
    XcdBarrier b; b.bar = bar; b.x = xb_xcc_id(); b.st = st;
    if (leader) (void)xb_add(&bar[XB_XCNT(b.x)], 1u);
    return b;
}
__device__ __forceinline__ void xcd_barrier_complete(unsigned* bar, unsigned x, unsigned& nloc, unsigned& nx) {
    const unsigned G = gridDim.x * gridDim.y * gridDim.z;
    unsigned sum, cnt, mine, sp = 0u;
    for (;;) {
        sum = 0u; cnt = 0u; mine = 0u;
#pragma unroll
        for (unsigned j = 0; j < 16; ++j) { const unsigned c = xb_ld(&bar[XB_XCNT(j)]); sum += c; cnt += (c > 0u) ? 1u : 0u; mine = (j == x) ? c : mine; }
        if (sum == G) break;
        __builtin_amdgcn_s_sleep(1);
        if ((++sp & 255u) == 0u) { if (xb_ld(&bar[XB_TMO])) break; if (sp > XB_SPIN_CAP) { atomicAdd(&bar[XB_TMO], 1u); break; } }
    }
    nloc = mine > 0u ? mine : 1u; nx = cnt > 0u ? cnt : 1u;
}
__device__ __forceinline__ void xcd_barrier(const XcdBarrier& b, bool leader  ) {
    asm volatile("s_waitcnt vmcnt(0)" ::: "memory");
    __syncthreads();
    if (leader) {
        unsigned* bar = b.bar; asm volatile("" : "+s"(bar));
        __builtin_amdgcn_s_waitcnt(0);
        unsigned nloc = b.st[0], nx = b.st[1];
        if (nloc == 0u) { xcd_barrier_complete(bar, b.x, nloc, nx); b.st[0] = nloc; b.st[1] = nx; }
        const unsigned old = xb_add(&bar[XB_XSUB(b.x)], 1u);
        const unsigned gen = old / nloc;
        if (old + 1u == (gen + 1u) * nloc) {
            __builtin_amdgcn_fence(__ATOMIC_RELEASE, "agent");
            asm volatile("s_waitcnt vmcnt(0)" ::: "memory");
            const unsigned og = xb_add(&bar[XB_TOP], 1u);
            const unsigned tg = og / nx;
            if (og + 1u == (tg + 1u) * nx) xb_add(&bar[XB_TOPGEN], 1u);
            else XB_SPIN(xb_ld(&bar[XB_TOPGEN]) == tg, bar);
            __builtin_amdgcn_fence(__ATOMIC_ACQUIRE, "agent");
            xb_add(&bar[XB_XGEN(b.x)], 1u);
            asm volatile("s_waitcnt vmcnt(0)" ::: "memory");
        } else {
            XB_SPIN(xb_ld(&bar[XB_XGEN(b.x)]) == gen, bar);
            __builtin_amdgcn_fence(__ATOMIC_ACQUIRE, "agent");
            asm volatile("s_waitcnt vmcnt(0)" ::: "memory");
        }
    }
    __syncthreads();
}

__device__ __forceinline__ void tr_item(const float* W, int ldw, int k0, int nsrc0, int nvalid, bf16* WT, int ldk, int kdst0, int rdst0, float scale, LAS float* scr, int lane) {
    const int kr = lane >> 3, nc = (lane & 7) * 4;
#pragma unroll
    for (int i = 0; i < 8; ++i) { f32x4 v = (f32x4){0.f, 0.f, 0.f, 0.f};
        if (nc < nvalid) v = *(const f32x4*)(W + (size_t)(k0 + 8 * i + kr) * ldw + nsrc0 + nc);
        LAS float* s = scr + (8 * i + kr) * 33 + nc; s[0] = v[0] * scale; s[1] = v[1] * scale; s[2] = v[2] * scale; s[3] = v[3] * scale; }
    asm volatile("s_waitcnt lgkmcnt(0)" ::: "memory");
    const int c = lane & 7;
#pragma unroll
    for (int j = 0; j < 4; ++j) { const int n = (lane >> 3) + 8 * j; const LAS float* s = scr + (8 * c) * 33 + n;
        u32x4 o; o.x = cvt_pk_bf16(s[0 * 33], s[1 * 33]); o.y = cvt_pk_bf16(s[2 * 33], s[3 * 33]); o.z = cvt_pk_bf16(s[4 * 33], s[5 * 33]); o.w = cvt_pk_bf16(s[6 * 33], s[7 * 33]);
        *(u32x4*)(WT + (size_t)(rdst0 + n) * ldk + kdst0 + k0 + 8 * c) = o; }
    asm volatile("s_waitcnt lgkmcnt(0)" ::: "memory");
}

__device__ __forceinline__ void tr_item8(const float* W, int ldw, int k0, int nsrc0, unsigned char* WT, int ldk, int rdst0, float scale, LAS float* scr, int lane) {
    const int kr = lane >> 3, nc = (lane & 7) * 4;
#pragma unroll
    for (int i = 0; i < 8; ++i) { const f32x4 v = *(const f32x4*)(W + (size_t)(k0 + 8 * i + kr) * ldw + nsrc0 + nc);
        LAS float* s = scr + (8 * i + kr) * 33 + nc; s[0] = v[0] * scale; s[1] = v[1] * scale; s[2] = v[2] * scale; s[3] = v[3] * scale; }
    asm volatile("s_waitcnt lgkmcnt(0)" ::: "memory");
    const int c = lane & 3;
#pragma unroll
    for (int j = 0; j < 2; ++j) { const int n = (lane >> 2) + 16 * j; const LAS float* s = scr + (16 * c) * 33 + n;
        u32x4 o; o.x = pack4_fp8(s[0 * 33], s[1 * 33], s[2 * 33], s[3 * 33]); o.y = pack4_fp8(s[4 * 33], s[5 * 33], s[6 * 33], s[7 * 33]);
        o.z = pack4_fp8(s[8 * 33], s[9 * 33], s[10 * 33], s[11 * 33]); o.w = pack4_fp8(s[12 * 33], s[13 * 33], s[14 * 33], s[15 * 33]);
        *(u32x4*)(WT + (size_t)(rdst0 + n) * ldk + k0 + 16 * c) = o; }
    asm volatile("s_waitcnt lgkmcnt(0)" ::: "memory");
}

struct Args { const float* in[25]; float* out; unsigned char* ws; int ph_lo, ph_hi; };
static_assert(sizeof(Args) == 25 * 8 + 8 + 8 + 8, "Args has no padding");

struct TrDesc { const float* src; int ldw; unsigned char* dst; int pitch; float scale; int fp8; };
__device__ __forceinline__ TrDesc tr_desc(const float* W, int ldw, int k0, int nsrc0, void* WT, int ldk, int kdst0, int rdst0, float scale, int fp8) {
    TrDesc d; d.src = W + (size_t)k0 * ldw + nsrc0; d.ldw = ldw; d.scale = scale; d.fp8 = fp8;
    d.pitch = fp8 ? ldk : 2 * ldk; d.dst = (unsigned char*)WT + (size_t)rdst0 * d.pitch + (size_t)(kdst0 + k0) * (fp8 ? 1 : 2); return d;
}
__device__ __forceinline__ void tr_load(const TrDesc& d, f32x4 (&v)[8], int lane) {
    const int kr = lane >> 3, nc = (lane & 7) * 4;
#pragma unroll
    for (int i = 0; i < 8; ++i) v[i] = __builtin_nontemporal_load((const f32x4*)(d.src + (size_t)(8 * kr + i) * d.ldw + nc));
}
__device__ __forceinline__ void tr_process(const TrDesc& d, const f32x4 (&v)[8], LAS float* scr, int lane) {
    LAS unsigned char* sb = (LAS unsigned char*)scr;
    const int kr = lane >> 3, nq = lane & 7; const float sc = d.scale;
    if (d.fp8) {
#pragma unroll
        for (int e = 0; e < 4; ++e) { u32x2 w;
            w.x = pack4_fp8(v[0][e] * sc, v[1][e] * sc, v[2][e] * sc, v[3][e] * sc); w.y = pack4_fp8(v[4][e] * sc, v[5][e] * sc, v[6][e] * sc, v[7][e] * sc);
            *(LAS u32x2*)(sb + (8 * e + nq) * 80 + 8 * kr) = w; }
        const int c = lane & 3;
#pragma unroll
        for (int j = 0; j < 2; ++j) { const int n = (lane >> 2) + 16 * j; const u32x4 o = *(const LAS u32x4*)(sb + (((n & 3) << 3) | (n >> 2)) * 80 + 16 * c);
            __builtin_nontemporal_store(o, (u32x4*)(d.dst + (size_t)n * d.pitch + 16 * c)); }
    } else {
#pragma unroll
        for (int e = 0; e < 4; ++e) { u32x4 w;
            w.x = cvt_pk_bf16(v[0][e] * sc, v[1][e] * sc); w.y = cvt_pk_bf16(v[2][e] * sc, v[3][e] * sc); w.z = cvt_pk_bf16(v[4][e] * sc, v[5][e] * sc); w.w = cvt_pk_bf16(v[6][e] * sc, v[7][e] * sc);
            *(LAS u32x4*)(sb + (8 * e + nq) * 144 + 16 * kr) = w; }
        const int c = lane & 7;
#pragma unroll
        for (int j = 0; j < 4; ++j) { const int n = (lane >> 3) + 8 * j; const u32x4 o = *(const LAS u32x4*)(sb + (((n & 3) << 3) | (n >> 2)) * 144 + 16 * c);
            __builtin_nontemporal_store(o, (u32x4*)(d.dst + (size_t)n * d.pitch + 16 * c)); }
    }
    asm volatile("s_waitcnt lgkmcnt(0)" ::: "memory");
}
__device__ __forceinline__ TrDesc p0_item(const Args& P, int it) {
    bf16* ws_win = (bf16*)(P.ws + WS_WIN); bf16* ws_wbr = (bf16*)(P.ws + WS_WBR); bf16* ws_wout = (bf16*)(P.ws + WS_WOUT);
    bf16* ws_wgu = (bf16*)(P.ws + WS_WGU); bf16* ws_wd = (bf16*)(P.ws + WS_WD); unsigned char* ws_egu = P.ws + WS_EGU; unsigned char* ws_ed = P.ws + WS_ED;
    constexpr int I_QKV = 32 * 160, I_GT = 32 * 192, I_BA = 12 * 64, I_BB = 8 * 64, I_BC = 12 * 64, I_WO = 32 * 64;
    constexpr int I_LAYER = I_QKV + I_GT + I_BA + I_BB + I_BC + I_WO;
    constexpr int I_DG = 32 * 176, I_DD = 88 * 64;
    constexpr int I_EG = 32 * 224, I_ED = 112 * 64;
    int r = it;
    if (r < 2 * I_LAYER) {
        const int l = r / I_LAYER; r -= l * I_LAYER;
        const float* w_in = P.in[2] + (size_t)l * DM * DIN_SRC; bf16* win_t = ws_win + (size_t)l * NIN * DM;
        if (r < I_QKV) { const int kb = r / 160, nb = r % 160, n0 = nb * 32;
            const bool isq = (n0 < 768) || (n0 >= 1280 && n0 < 1792) || (n0 >= 2816 && n0 < 3584);
            return tr_desc(w_in, DIN_SRC, kb * 64, n0, win_t, DM, 0, n0, isq ? QSCALE : 1.f, 0); } r -= I_QKV;
        if (r < I_GT) { const int kb = r / 192, nb = r % 192;
            if ((MK_FP8_GATES >> l) & 1) return tr_desc(w_in, DIN_SRC, kb * 64, 5132 + nb * 32, win_t + (size_t)5120 * DM, DM, 0, nb * 32, F8_SWG, 1);
            return tr_desc(w_in, DIN_SRC, kb * 64, 5132 + nb * 32, win_t, DM, 0, 5120 + nb * 32, 1.f, 0); } r -= I_GT;
        bf16* wbr_t = ws_wbr + (size_t)l * DM * DM;
        if (r < I_BA) { const int kb = r / 64, nb = r % 64; return tr_desc(P.in[11] + (size_t)l * 768 * DM, DM, kb * 64, nb * 32, wbr_t, DM, 0, nb * 32, 1.f, 0); } r -= I_BA;
        if (r < I_BB) { const int kb = r / 64, nb = r % 64; return tr_desc(P.in[12] + (size_t)l * 512 * DM, DM, kb * 64, nb * 32, wbr_t, DM, 768, nb * 32, 1.f, 0); } r -= I_BB;
        if (r < I_BC) { const int kb = r / 64, nb = r % 64; return tr_desc(P.in[13] + (size_t)l * 768 * DM, DM, kb * 64, nb * 32, wbr_t, DM, 1280, nb * 32, 1.f, 0); } r -= I_BC;
        { const int kb = r / 64, nb = r % 64; return tr_desc(P.in[14] + (size_t)l * DM * DM, DM, kb * 64, nb * 32, ws_wout + (size_t)l * DM * DM, DM, 0, nb * 32, 1.f, 0); }
    }
    r -= 2 * I_LAYER;
    if (r < 2 * I_DG) { const int up = r / I_DG; r -= up * I_DG; const int kb = r / 176, nb = r % 176, n0 = nb * 32;
        return tr_desc(up ? P.in[19] : P.in[18], DFF, kb * 64, n0, ws_wgu, DM, 0, (n0 >> 7) * 256 + ((n0 >> 5) & 3) * 64 + up * 32, MK_FP8_DUP ? F8_SWU : 1.f, MK_FP8_DUP); } r -= 2 * I_DG;
    if (r < I_DD) { const int kb = r / 64, nb = r % 64; return tr_desc(P.in[20], DM, kb * 64, nb * 32, ws_wd, DFF, 0, nb * 32, MK_FP8_DDOWN ? F8_SWD : 1.f, MK_FP8_DDOWN); } r -= I_DD;
    { const int e = r / (2 * I_EG + I_ED); r -= e * (2 * I_EG + I_ED);
      if (r < 2 * I_EG) { const int up = r / I_EG; r -= up * I_EG; const int kb = r / 224, nb = r % 224, n0 = nb * 32;
          return tr_desc((up ? P.in[23] : P.in[22]) + (size_t)e * DM * DFE, DFE, kb * 64, n0, ws_egu + (size_t)e * 2 * DFE * DM, DM, 0, (n0 >> 7) * 256 + ((n0 >> 5) & 3) * 64 + up * 32, F8_SWU, 1); } r -= 2 * I_EG;
      { const int kb = r / 64, nb = r % 64; return tr_desc(P.in[24] + (size_t)e * DFE * DM, DM, kb * 64, nb * 32, ws_ed + (size_t)e * DM * DFE, DFE, 0, nb * 32, F8_SWD, 1); } }
}
constexpr int NI_BASE = 2 * (32 * 160 + 32 * 192 + 12 * 64 + 8 * 64 + 12 * 64 + 32 * 64) + 2 * 32 * 176 + 88 * 64;
constexpr int NI_MOE = NEXP * (2 * 32 * 224 + 112 * 64);
constexpr int NI_P0 = 32 * 160 + 32 * 192;
constexpr int CONV_ITEMS = 128;
constexpr int CONV_L0_START = NI_P0, CONV_L0_UNITS = 816, CONV_L1_START = CONV_L0_START + CONV_L0_UNITS * CONV_ITEMS, CONV_L1_UNITS = (NI_BASE + NI_MOE - CONV_L1_START) / CONV_ITEMS;
static_assert((NI_BASE - NI_P0) % CONV_ITEMS == 0 && (NI_BASE + NI_MOE - CONV_L1_START) % CONV_ITEMS == 0 && CONV_L1_START > NI_BASE, "conversion units are whole; layer 0 takes all the small matrices");
__device__ __forceinline__ void tr_walk(const Args& P, LAS unsigned char* lds, int first, int step, int end, int wave, int lane) {
    LAS float* scr = (LAS float*)(lds + RING_OFF + wave * 16384);
    if (first >= end) return;
    TrDesc d0 = p0_item(P, first); f32x4 v[8]; tr_load(d0, v, lane);
    for (int it = first; it < end; it += step) {
        const bool has = (it + step < end);
        TrDesc d1 = d0; f32x4 w[8];
        if (has) { d1 = p0_item(P, it + step); tr_load(d1, w, lane); }
        tr_process(d0, v, scr, lane);
        if (has) { d0 = d1;
#pragma unroll
            for (int i = 0; i < 8; ++i) v[i] = w[i]; }
    }
}
__device__ __forceinline__ void p0_prologue(const Args& P, LAS unsigned char* lds, int gw, int NGW, int wave, int lane) { tr_walk(P, lds, gw, NGW, NI_P0, wave, lane); }
__device__ __forceinline__ void conv_unit(const Args& P, LAS unsigned char* lds, int layer, int u, int wave, int lane) {
    const int base = (layer ? CONV_L1_START : CONV_L0_START) + u * CONV_ITEMS;
    tr_walk(P, lds, base + wave, NWAVES, base + CONV_ITEMS, wave, lane);
}

__device__ __forceinline__ void ld_row_f32(const float* p, int lane, f32x4 (&v)[8]) {
#pragma unroll
    for (int j = 0; j < 8; ++j) v[j] = *(const f32x4*)(p + 4 * lane + 256 * j);
}
__device__ __forceinline__ void ld_row_bf16(const bf16* p, int lane, f32x4 (&v)[8]) {
#pragma unroll
    for (int j = 0; j < 8; ++j) { const u32x2 w = *(const u32x2*)(p + 4 * lane + 256 * j); v[j] = (f32x4){bf_lo(w.x), bf_hi(w.x), bf_lo(w.y), bf_hi(w.y)}; }
}
__device__ __forceinline__ void st_row_f32(float* p, int lane, const f32x4 (&v)[8]) {
#pragma unroll
    for (int j = 0; j < 8; ++j) *(f32x4*)(p + 4 * lane + 256 * j) = v[j];
}
__device__ __forceinline__ void st_row_bf16(bf16* p, int lane, const f32x4 (&v)[8]) {
#pragma unroll
    for (int j = 0; j < 8; ++j) { u32x2 w; w.x = cvt_pk_bf16(v[j][0], v[j][1]); w.y = cvt_pk_bf16(v[j][2], v[j][3]); *(u32x2*)(p + 4 * lane + 256 * j) = w; }
}
__device__ __forceinline__ float row_rstd(const f32x4 (&v)[8]) {
    float s = 0.f;
#pragma unroll
    for (int j = 0; j < 8; ++j) s += (v[j][0] * v[j][0] + v[j][1] * v[j][1]) + (v[j][2] * v[j][2] + v[j][3] * v[j][3]);
    return rsqrtf(wave_sum(s) * (1.f / DM) + RMS_EPS);
}
__device__ __forceinline__ void fc_stage(const float* w_in, LAS unsigned char* lds, int tid) {
    LAS float* wl = (LAS float*)lds;
    for (int k = tid; k < DM; k += 512) { const float* p = w_in + (size_t)k * DIN_SRC + 5120; const f32x4 a = *(const f32x4*)p, b = *(const f32x4*)(p + 4), c = *(const f32x4*)(p + 8);
        wl[0 * DM + k] = a[0]; wl[1 * DM + k] = a[1]; wl[2 * DM + k] = a[2]; wl[3 * DM + k] = a[3]; wl[4 * DM + k] = b[0]; wl[5 * DM + k] = b[1]; wl[6 * DM + k] = b[2]; wl[7 * DM + k] = b[3];
        wl[8 * DM + k] = c[0]; wl[9 * DM + k] = c[1]; wl[10 * DM + k] = c[2]; wl[11 * DM + k] = c[3]; }
    __syncthreads();
}
__device__ __forceinline__ void fc_row(const f32x4 (&v)[8], const LAS unsigned char* lds, const float* bforget, float* LFrow, int lane) {
    const LAS float* wl = (const LAS float*)lds; float mine = 0.f;
#pragma unroll
    for (int c = 0; c < 12; ++c) { float s = 0.f;
#pragma unroll
        for (int j = 0; j < 8; ++j) { const f32x4 w = *(const LAS f32x4*)(wl + c * DM + 4 * lane + 256 * j); s += (v[j][0] * w[0] + v[j][1] * w[1]) + (v[j][2] * w[2] + v[j][3] * w[3]); }
        s = wave_sum(s); mine = (lane == c) ? s : mine; }
    if (lane < 12) { const float x = mine + bforget[lane];
        LFrow[lane] = fminf(x, 0.f) - 0.6931471805599453f * __builtin_amdgcn_logf(1.f + __builtin_amdgcn_exp2f(-LOG2E * fabsf(x))); }
}
__device__ __forceinline__ void st_row_fp8(unsigned char* p, int lane, const f32x4 (&v)[8], float s) {
#pragma unroll
    for (int j = 0; j < 8; ++j) *(unsigned*)(p + 4 * lane + 256 * j) = pack4_fp8(v[j][0] * s, v[j][1] * s, v[j][2] * s, v[j][3] * s);
}
__device__ __forceinline__ void rows_norm_only(const float* x, const float* g, bf16* H, unsigned char* H8, const float* w_in, const float* bforget, float* LF, LAS unsigned char* lds, int tid, int gw, int NGW, int lane) {
    fc_stage(w_in, lds, tid);
    f32x4 gv[8]; ld_row_f32(g, lane, gv);
    for (int m = gw; m < T_TOK; m += NGW) { f32x4 v[8]; ld_row_f32(x + (size_t)m * DM, lane, v); const float r = row_rstd(v);
#pragma unroll
        for (int j = 0; j < 8; ++j) v[j] = (v[j] * r) * gv[j];
        st_row_bf16(H + (size_t)m * DM, lane, v);
        if (H8) st_row_fp8(H8 + (size_t)m * DM, lane, v, F8_SH);
        fc_row(v, lds, bforget, LF + (size_t)m * 16, lane); }
}
constexpr int RT_W = 0, RT_CNT = 65536, RT_BASE = 65536 + 64, RT_ROW = 65536 + 128;
template <bool ROUTE, bool XINB, bool HF8 = ROUTE>
__device__ __forceinline__ void rows_post_mixer(const void* xin, bf16* xout, const bf16* Mo, const float* g1, const float* g2, bf16* H, const float* w_router,
                                                unsigned* ecnt, int* list, float* tokinfo, LAS unsigned char* lds, int r0, int r1, int tid) {
    const int lane = tid & 63, wave = __builtin_amdgcn_readfirstlane(tid >> 6);
    if (ROUTE) {
        LAS float* wl = (LAS float*)(lds + RT_W);
        for (int k = tid; k < DM; k += 512) { const f32x4 a = *(const f32x4*)(w_router + (size_t)k * 8), b = *(const f32x4*)(w_router + (size_t)k * 8 + 4);
            wl[0 * DM + k] = a[0]; wl[1 * DM + k] = a[1]; wl[2 * DM + k] = a[2]; wl[3 * DM + k] = a[3]; wl[4 * DM + k] = b[0]; wl[5 * DM + k] = b[1]; wl[6 * DM + k] = b[2]; wl[7 * DM + k] = b[3]; }
        if (tid < 8) ((LAS unsigned*)(lds + RT_CNT))[tid] = 0u;
        __syncthreads();
    }
    f32x4 gv1[8], gv2[8]; ld_row_f32(g1, lane, gv1); ld_row_f32(g2, lane, gv2);
    for (int m = r0 + wave; m < r1; m += NWAVES) {
        f32x4 v[8], xv[8]; ld_row_bf16(Mo + (size_t)m * DM, lane, v);
        if (XINB) ld_row_bf16((const bf16*)xin + (size_t)m * DM, lane, xv); else ld_row_f32((const float*)xin + (size_t)m * DM, lane, xv);
        const float r = row_rstd(v);
#pragma unroll
        for (int j = 0; j < 8; ++j) xv[j] = xv[j] + (v[j] * r) * gv1[j];
        st_row_bf16(xout + (size_t)m * DM, lane, xv);
        const float r2 = row_rstd(xv);
#pragma unroll
        for (int j = 0; j < 8; ++j) v[j] = (xv[j] * r2) * gv2[j];
        if (HF8) {
#pragma unroll
            for (int j = 0; j < 8; ++j) *(unsigned*)((unsigned char*)H + (size_t)m * DM + 4 * lane + 256 * j) = pack4_fp8(v[j][0] * F8_SH, v[j][1] * F8_SH, v[j][2] * F8_SH, v[j][3] * F8_SH);
        } else st_row_bf16(H + (size_t)m * DM, lane, v);
        if (ROUTE) {
            const LAS float* wl = (const LAS float*)(lds + RT_W);
            float lg[8];
#pragma unroll
            for (int e = 0; e < 8; ++e) { float s = 0.f;
#pragma unroll
                for (int j = 0; j < 8; ++j) { const f32x4 w = *(const LAS f32x4*)(wl + e * DM + 4 * lane + 256 * j); s += (v[j][0] * w[0] + v[j][1] * w[1]) + (v[j][2] * w[2] + v[j][3] * w[3]); }
                lg[e] = wave_sum(s); }
            if (lane == 0) {
                int i1 = 0; float v1 = lg[0];
#pragma unroll
                for (int e = 1; e < 8; ++e) if (lg[e] > v1) { v1 = lg[e]; i1 = e; }
                int i2 = -1; float v2 = -INFINITY;
#pragma unroll
                for (int e = 0; e < 8; ++e) if (e != i1 && (i2 < 0 || lg[e] > v2)) { v2 = lg[e]; i2 = e; }
                const float ex = expf(v2 - v1), w1 = 1.f / (1.f + ex), w2 = ex * w1;
                LAS unsigned* lc = (LAS unsigned*)(lds + RT_CNT);
                const unsigned lp1 = __hip_atomic_fetch_add(&lc[i1], 1u, __ATOMIC_RELAXED, __HIP_MEMORY_SCOPE_WORKGROUP), lp2 = __hip_atomic_fetch_add(&lc[i2], 1u, __ATOMIC_RELAXED, __HIP_MEMORY_SCOPE_WORKGROUP);
                LAS unsigned* rr = (LAS unsigned*)(lds + RT_ROW) + (m - r0) * 8;
                rr[0] = (unsigned)i1; rr[1] = (unsigned)i2; rr[2] = lp1; rr[3] = lp2; rr[4] = __float_as_uint(w1); rr[5] = __float_as_uint(w2);
            }
        }
    }
    if (ROUTE) {
        __syncthreads();
        if (tid < 8) { const unsigned c = ((LAS unsigned*)(lds + RT_CNT))[tid]; ((LAS unsigned*)(lds + RT_BASE))[tid] = c ? __hip_atomic_fetch_add(ecnt + tid, c, __ATOMIC_RELAXED, __HIP_MEMORY_SCOPE_AGENT) : 0u; }
        __syncthreads();
        for (int i = tid; i < r1 - r0; i += 512) { const LAS unsigned* rr = (const LAS unsigned*)(lds + RT_ROW) + i * 8; const LAS unsigned* bs = (const LAS unsigned*)(lds + RT_BASE);
            const unsigned e1 = rr[0], e2 = rr[1], p1 = bs[e1] + rr[2], p2 = bs[e2] + rr[3]; const int tok = r0 + i;
            list[(size_t)e1 * CAP + p1] = tok; list[(size_t)e2 * CAP + p2] = tok;
            f32x4 a, b; a[0] = __uint_as_float(e1); a[1] = __uint_as_float(p1); a[2] = __uint_as_float(e2); a[3] = __uint_as_float(p2); b[0] = __uint_as_float(rr[4]); b[1] = __uint_as_float(rr[5]); b[2] = 0.f; b[3] = 0.f;
            *(f32x4*)(tokinfo + (size_t)tok * 8) = a; *(f32x4*)(tokinfo + (size_t)tok * 8 + 4) = b; }
        __syncthreads();
    }
}
template <bool MOE, bool NEXTH>
__device__ __forceinline__ void rows_post_ffn(bf16* xb, float* xfinal, const bf16* F, const float* tokinfo, const LAS int* tbl, const float* g1, const float* g2, bf16* H, unsigned char* H8, const float* w_in, const float* bforget, float* LF, LAS unsigned char* lds, int tid, int gw, int NGW, int lane, int fmode = 0  , int rtf = 0) {
    if (NEXTH) fc_stage(w_in, lds, tid);
    f32x4 gv1[8], gv2[8]; ld_row_f32(g1, lane, gv1); if (NEXTH) ld_row_f32(g2, lane, gv2);
    for (int m = gw; m < T_TOK; m += NGW) {
        f32x4 v[8], xv[8];
        if (MOE) { const f32x4 a = *(const f32x4*)(tokinfo + (size_t)m * 8); const f32x2 wv = *(const f32x2*)(tokinfo + (size_t)m * 8 + 4);
            const int e1 = (int)__float_as_uint(a[0]), p1 = (int)__float_as_uint(a[1]), e2 = (int)__float_as_uint(a[2]), p2 = (int)__float_as_uint(a[3]);
            const size_t s1 = (size_t)tbl[e1] * 256 + p1, s2 = (size_t)tbl[e2] * 256 + p2;
            if (fmode) { const bool ready = __builtin_amdgcn_readfirstlane((int)(((int)(s1 >> 8) < rtf) && ((int)(s2 >> 8) < rtf))) != 0; if ((fmode == 1) != ready) continue; }
            const unsigned char* Y8 = (const unsigned char*)F; const float w1s = wv[0] * (1.f / F8_SY), w2s = wv[1] * (1.f / F8_SY);
#pragma unroll
            for (int j = 0; j < 8; ++j) { const unsigned a8 = *(const unsigned*)(Y8 + s1 * DM + 4 * lane + 256 * j), b8 = *(const unsigned*)(Y8 + s2 * DM + 4 * lane + 256 * j);
                const f32x2 al = __builtin_amdgcn_cvt_pk_f32_fp8((int)a8, false), ah = __builtin_amdgcn_cvt_pk_f32_fp8((int)a8, true), bl = __builtin_amdgcn_cvt_pk_f32_fp8((int)b8, false), bh = __builtin_amdgcn_cvt_pk_f32_fp8((int)b8, true);
                v[j] = (f32x4){al[0] * w1s + bl[0] * w2s, al[1] * w1s + bl[1] * w2s, ah[0] * w1s + bh[0] * w2s, ah[1] * w1s + bh[1] * w2s}; }
        } else ld_row_bf16(F + (size_t)m * DM, lane, v);
        ld_row_bf16(xb + (size_t)m * DM, lane, xv);
        const float r = row_rstd(v);
#pragma unroll
        for (int j = 0; j < 8; ++j) xv[j] = xv[j] + (v[j] * r) * gv1[j];
        if (NEXTH) st_row_bf16(xb + (size_t)m * DM, lane, xv); else st_row_f32(xfinal + (size_t)m * DM, lane, xv);
        if (NEXTH) { const float r2 = row_rstd(xv);
#pragma unroll
            for (int j = 0; j < 8; ++j) v[j] = (xv[j] * r2) * gv2[j];
            st_row_bf16(H + (size_t)m * DM, lane, v);
            if (H8) st_row_fp8(H8 + (size_t)m * DM, lane, v, F8_SH);
            fc_row(v, lds, bforget, LF + (size_t)m * 16, lane); }
    }
}

constexpr int N_PHASES = 17;
__global__ void __launch_bounds__(NWAVES * 64, 2) mk_fwd(Args args) {
    extern __shared__ __attribute__((aligned(16))) unsigned char lds_raw[];
    LAS unsigned char* lds = (LAS unsigned char*)lds_raw;
    volatile LAS unsigned* MISC = (volatile LAS unsigned*)(lds + MISC_OFF);
    const int wave_s = __builtin_amdgcn_readfirstlane((int)threadIdx.x >> 6);
#define TID_NOW() ({ int z_ = 0; asm volatile("" : "+v"(z_)); wave_s * 64 + (int)__builtin_amdgcn_mbcnt_hi(~0u, __builtin_amdgcn_mbcnt_lo(~0u, (unsigned)z_)); })
    const int G = gridDim.x; const int bx = blockIdx.x; const int vcu = (G % 8 == 0) ? (bx % 8) * (G / 8) + bx / 8 : bx;
    const int NGW = G * NWAVES;
    auto ptid = [wave_s]() __attribute__((always_inline)) { int z_ = 0; asm volatile("" : "+v"(z_)); return wave_s * 64 + (int)__builtin_amdgcn_mbcnt_hi(~0u, __builtin_amdgcn_mbcnt_lo(~0u, (unsigned)z_)); };
    const Args& P = args;
    unsigned* ctl0 = (unsigned*)(P.ws + WS_CTL);
    for (int u = TID_NOW(); u < (LDS_BYTES - LDSCTL_OFF) / 4; u += NWAVES * 64) ((LAS unsigned*)(lds + LDSCTL_OFF))[u] = 0u;
    __syncthreads();
    XcdBarrier bar; bar.bar = ctl0 + CW_BAR; bar.x = 0; bar.st = nullptr;
    if (MK_N_LAUNCHES == 1) bar = xcd_barrier_post(ctl0 + CW_BAR, MISC + 8, TID_NOW() == 0);
#define GRID_BAR() do { if (MK_N_LAUNCHES == 1) xcd_barrier(bar, TID_NOW() == 0); } while (0)
    const int lo = args.ph_lo, hi = args.ph_hi;
#define IN(k) (lo <= (k) && (k) < hi)
#define BOTH(k) (IN(k) && IN((k) + 1))

#define WS_VIEWS() unsigned char* ws_ = P.ws; asm volatile("" : "+s"(ws_)); \
    bf16* H = (bf16*)(ws_ + WS_H); bf16* Z = (bf16*)(ws_ + WS_Z); bf16* Gt = (bf16*)(ws_ + WS_G); bf16* O = (bf16*)(ws_ + WS_O); bf16* MG = (bf16*)(ws_ + WS_MG); \
    bf16* U = (bf16*)(ws_ + WS_U); bf16* Mo = (bf16*)(ws_ + WS_MO); bf16* Y = (bf16*)(ws_ + WS_Y); float* LF = (float*)(ws_ + WS_LF); \
    int* list = (int*)(ws_ + WS_LIST); float* tokinfo = (float*)(ws_ + WS_TOK); unsigned* ctl = (unsigned*)(ws_ + WS_CTL); \
    (void)H; (void)Z; (void)Gt; (void)O; (void)MG; (void)U; (void)Mo; (void)Y; (void)LF; (void)list; (void)tokinfo; (void)ctl
    LAS int* tbl = (LAS int*)(lds + LDSCTL_OFF);

    if (IN(0)) { WS_VIEWS();
        { const int t = ptid(), lane = t & 63, wave = __builtin_amdgcn_readfirstlane(t >> 6), gw = vcu * NWAVES + wave;
          p0_prologue(P, lds, gw, NGW, wave, lane);
          if (MK_PROBE_DUP == 1) { asm volatile("" ::: "memory"); p0_prologue(P, lds, gw, NGW, wave, lane); }
          __syncthreads();
          rows_norm_only(P.in[0], P.in[1], H, (MK_FP8_GATES & 1) ? ws_ + WS_H8 : nullptr, P.in[2], P.in[3], LF, lds, t, gw, NGW, lane); }
        if (BOTH(0)) GRID_BAR();
    }
    for (int layer = 0; layer < 2; ++layer) {
        const int pb = 1 + 8 * layer;
        if (IN(pb + 0)) { WS_VIEWS();
            const bf16* win_t = (const bf16*)(ws_ + WS_WIN) + (size_t)layer * NIN * DM;
            if ((MK_FP8_GATES >> layer) & 1) {
                { pg8::Gemm g{H, win_t, DM}; pg8::StaticOrder S; S.init(T_TOK / 256, 20, G, bx); pg8::EpiPlain E{Z, ZP, 1.f};
                  pg8::gemm_phase(ptid(), lds + RING_OFF, g, S, E); }
                { pg8::Gemm g{(const bf16*)(ws_ + WS_H8), win_t + (size_t)5120 * DM, DM / 2}; pg8::StaticOrder S; S.init(T_TOK / 256, 24, G, bx); pg8::EpiGates E{(unsigned char*)Gt, P.in[4] + (size_t)layer * GP, F8_GT_INV};
                  pg8::gemm_phase<pg8::EpiGates, pg8::StaticOrder, true>(ptid(), lds + RING_OFF, g, S, E); }
            } else {
                pg8::Gemm g{H, win_t, DM}; pg8::StaticOrder S; S.init(T_TOK / 256, 44, G, bx);
                pg8::EpiInProj E{Z, (unsigned char*)Gt, P.in[4] + (size_t)layer * GP};
                pg8::gemm_phase(ptid(), lds + RING_OFF, g, S, E);
            }
            if (BOTH(pb + 0)) GRID_BAR();
        }
        if (IN(pb + 1)) { WS_VIEWS();
            const int t = ptid(), lane = t & 63;
            att::Args A; A.Z = Z; A.O = O; A.LF = LF; A.sinks = P.in[5] + layer * 12; A.subln = P.in[10] + layer * 128;
            { float s1 = P.in[6][layer * 64 + lane] * P.in[7][layer * 64 + lane], s2 = P.in[8][layer * 64 + lane] * P.in[9][layer * 64 + lane];
              s1 = wave_sum(s1); s2 = wave_sum(s2);
              A.lam_init = 0.8f - 0.6f * expf(-0.3f * (float)layer); A.lam = expf(s1) - expf(s2) + A.lam_init; }
            unsigned* qhead = ctl + CW_ATTQ + 64 * layer;
            const unsigned nconv = layer ? (unsigned)CONV_L1_UNITS : (unsigned)CONV_L0_UNITS, NGRP = (nconv + 2u) / 3u, NQ1 = NGRP * 7u, NQ = NQ1 + ((unsigned)att::NUNITS - NGRP * 4u);
            static_assert(((CONV_L0_UNITS + 2) / 3) * 4 <= att::NUNITS && ((CONV_L1_UNITS + 2) / 3) * 4 <= att::NUNITS, "queue interleave");
            unsigned nxt = 0u; if (t == 0) nxt = __hip_atomic_fetch_add(qhead, 1u, __ATOMIC_RELAXED, __HIP_MEMORY_SCOPE_AGENT);
            for (;;) {
                if (t == 0) MISC[0] = nxt;
                __syncthreads();
                unsigned idx = MISC[0];
                __syncthreads();
                if (idx >= NQ * (MK_PROBE_DUP == 2 ? 4u : 1u)) break;
                if (t == 0) nxt = __hip_atomic_fetch_add(qhead, 1u, __ATOMIC_RELAXED, __HIP_MEMORY_SCOPE_AGENT);
                if (MK_PROBE_DUP == 2) idx %= NQ;
                int au = (int)(NGRP * 4u + (idx - NQ1)), cu = -1;
                if (idx < NQ1) { const unsigned grp = idx / 7u, rem = idx - grp * 7u; au = (int)(grp * 4u + rem); if (rem >= 4u) cu = (int)(grp * 3u + (rem - 4u)); }
                if (cu < 0) att::attn_unit(t, A, lds + RING_OFF, au);
                else if ((unsigned)cu < nconv) conv_unit(P, lds, layer, cu, __builtin_amdgcn_readfirstlane(t >> 6), lane);
            }
            if (BOTH(pb + 1)) GRID_BAR();
        }
        if (IN(pb + 2)) { WS_VIEWS();
            pg8::Gemm g{O, (const bf16*)(P.ws + WS_WBR) + (size_t)layer * DM * DM, DM}; pg8::StaticOrder S; S.init(T_TOK / 256, DM / 256, G, bx);
            pg8::EpiBranch E{(const unsigned char*)Gt, MG};
            int nrep = (MK_PROBE_DUP == 6) ? 2 : 1; asm volatile("" : "+s"(nrep));
            for (int rep = 0; rep < nrep; ++rep) pg8::gemm_phase(ptid(), lds + RING_OFF, g, S, E);
            if (BOTH(pb + 2)) GRID_BAR();
        }
        if (IN(pb + 3)) { WS_VIEWS();
            pg8::Gemm g{MG, (const bf16*)(P.ws + WS_WOUT) + (size_t)layer * DM * DM, DM}; pg8::StaticOrder S; S.init(T_TOK / 256, DM / 256, G, bx);
            pg8::EpiPlain E{Mo, DM, 1.f};
            int nrep = (MK_PROBE_DUP == 6) ? 2 : 1; asm volatile("" : "+s"(nrep));
            for (int rep = 0; rep < nrep; ++rep) pg8::gemm_phase(ptid(), lds + RING_OFF, g, S, E);
            if (BOTH(pb + 3)) GRID_BAR();
        }
        if (IN(pb + 4)) { WS_VIEWS();
            const int rpb = (T_TOK + G - 1) / G, r0 = vcu * rpb, r1 = (r0 + rpb < T_TOK) ? r0 + rpb : T_TOK;
            bf16* XB = (bf16*)(ws_ + WS_XB);
            if (layer == 0) rows_post_mixer<false, false, (MK_FP8_DUP != 0)>(P.in[0], XB, Mo, P.in[15] + layer * DM, P.in[16] + layer * DM, H, nullptr, nullptr, nullptr, nullptr, lds, r0, r1, ptid());
            else            rows_post_mixer<true, true>(XB, XB, Mo, P.in[15] + layer * DM, P.in[16] + layer * DM, H, P.in[21], ctl + CW_ECNT, list, tokinfo, lds, r0, r1, ptid());
            if (BOTH(pb + 4)) GRID_BAR();
        }
        if (layer == 0) {
            if (IN(pb + 5)) { WS_VIEWS();
                pg8::Gemm g{H, (const bf16*)(P.ws + WS_WGU), MK_FP8_DUP ? DM / 2 : DM}; pg8::StaticOrder S; S.init(T_TOK / 256, 2 * DFF / 256, G, bx);
                if (MK_FP8_DUP && MK_FP8_DDOWN) { pg8::EpiSwiGLU8 E{(unsigned char*)U, DFF, F8_UP_INV, F8_UP_INV * F8_SU}; pg8::gemm_phase<pg8::EpiSwiGLU8, pg8::StaticOrder, true>(ptid(), lds + RING_OFF, g, S, E); }
                else if (MK_FP8_DUP) { pg8::EpiSwiGLU E{U, DFF, F8_UP_INV}; pg8::gemm_phase<pg8::EpiSwiGLU, pg8::StaticOrder, true>(ptid(), lds + RING_OFF, g, S, E); }
                else if (MK_FP8_DDOWN) { pg8::EpiSwiGLU8 E{(unsigned char*)U, DFF, 1.f, F8_SU}; pg8::gemm_phase(ptid(), lds + RING_OFF, g, S, E); }
                else { pg8::EpiSwiGLU E{U, DFF}; pg8::gemm_phase(ptid(), lds + RING_OFF, g, S, E); }
                if (BOTH(pb + 5)) GRID_BAR();
            }
            if (IN(pb + 6)) { WS_VIEWS();
                if (MK_FP8_DDOWN) { pg8::Gemm g{U, (const bf16*)(P.ws + WS_WD), DFF / 2}; pg8::StaticOrder S; S.init(T_TOK / 256, DM / 256, G, bx);
                    pg8::EpiPlain E{Mo, DM, F8_DN_INV}; pg8::gemm_phase<pg8::EpiPlain, pg8::StaticOrder, true>(ptid(), lds + RING_OFF, g, S, E); }
                else { pg8::Gemm g{U, (const bf16*)(P.ws + WS_WD), DFF}; pg8::StaticOrder S; S.init(T_TOK / 256, DM / 256, G, bx);
                    pg8::EpiPlain E{Mo, DM, 1.f}; pg8::gemm_phase(ptid(), lds + RING_OFF, g, S, E); }
                if (BOTH(pb + 6)) GRID_BAR();
            }
            if (IN(pb + 7)) { WS_VIEWS();
                const int t = ptid(), lane = t & 63, gw = vcu * NWAVES + __builtin_amdgcn_readfirstlane(t >> 6);
                rows_post_ffn<false, true>((bf16*)(ws_ + WS_XB), nullptr, Mo, nullptr, tbl, P.in[17] + layer * DM, P.in[1] + (layer + 1) * DM, H, (MK_FP8_GATES & 2) ? ws_ + WS_H8 : nullptr, P.in[2] + (size_t)(layer + 1) * DM * DIN_SRC, P.in[3] + (layer + 1) * 12, LF, lds, t, gw, NGW, lane);
                if (BOTH(pb + 7)) GRID_BAR();
            }
        } else {
            if (IN(pb + 5) || IN(pb + 6) || IN(pb + 7)) { WS_VIEWS();
                if (TID_NOW() == 0) { int ts = 0;
                    for (int e = 0; e < 8; ++e) { const int c = (int)__hip_atomic_load(ctl + CW_ECNT + e, __ATOMIC_RELAXED, __HIP_MEMORY_SCOPE_AGENT); tbl[e] = ts; tbl[16 + e] = c; ts += (c + 255) >> 8; }
                    tbl[8] = ts; }
                __syncthreads();
            }
            if (IN(pb + 5)) { WS_VIEWS();
                pg8::Gemm g{H, (const bf16*)(P.ws + WS_EGU), DM / 2}; pg8::MoeOrder<true> S; S.init(__builtin_amdgcn_readfirstlane(tbl[8]), 2 * DFE / 256, G, bx); S.tbl = tbl; S.list = list;
                pg8::EpiSwiGLU8 E{(unsigned char*)U, DFE, F8_UP_INV, F8_UP_INV * F8_SU};
                int nrep = (MK_PROBE_DUP == 4) ? 2 : 1; asm volatile("" : "+s"(nrep));
                for (int rep = 0; rep < nrep; ++rep) pg8::gemm_phase<pg8::EpiSwiGLU8, pg8::MoeOrder<true>, true>(ptid(), lds + RING_OFF, g, S, E);
                if (BOTH(pb + 5)) GRID_BAR();
            }
            if (IN(pb + 6)) { WS_VIEWS();
                pg8::Gemm g{U, (const bf16*)(P.ws + WS_ED), DFE / 2}; pg8::DownOrder S; S.setup(__builtin_amdgcn_readfirstlane(tbl[8]), DM / 256, G, bx); S.tbl = tbl; S.list = list;
                pg8::EpiPlain8 E{(unsigned char*)Y, DM, F8_DN_INV * F8_SY};
                int npass = 2; asm volatile("" : "+s"(npass));
                for (int pass = 0; pass < npass; ++pass) { S.pass = pass;
                    pg8::gemm_phase<pg8::EpiPlain8, pg8::DownOrder, true>(ptid(), lds + RING_OFF, g, S, E);
                    if (pass == 0 && S.nrem_units > 0) {
                        asm volatile("s_waitcnt vmcnt(0)" ::: "memory"); __syncthreads();
                        if (TID_NOW() == 0) { __builtin_amdgcn_fence(__ATOMIC_RELEASE, "agent"); asm volatile("s_waitcnt vmcnt(0)" ::: "memory");
                            (void)__hip_atomic_fetch_add(ctl + CW_MD, 1u, __ATOMIC_RELAXED, __HIP_MEMORY_SCOPE_AGENT); } } }
                if (S.nrem_units > 0 && bx >= S.nrem_units) {
                    if (TID_NOW() == 0) { unsigned sp = 0, ok = 1u;
                        while (__hip_atomic_load(ctl + CW_MD, __ATOMIC_RELAXED, __HIP_MEMORY_SCOPE_AGENT) < (unsigned)G) { __builtin_amdgcn_s_sleep(2); if (++sp > (1u << 22)) { ok = 0u; break; } }
                        __builtin_amdgcn_fence(__ATOMIC_ACQUIRE, "agent"); MISC[1] = ok; }
                    __syncthreads();
                    if (MISC[1]) { const int t = ptid(), lane = t & 63, nidle = G - S.nrem_units, gw2 = (bx - S.nrem_units) * NWAVES + __builtin_amdgcn_readfirstlane(t >> 6);
                        rows_post_ffn<true, false>((bf16*)(ws_ + WS_XB), P.out, Y, tokinfo, tbl, P.in[17] + layer * DM, nullptr, nullptr, nullptr, nullptr, nullptr, nullptr, lds, t, gw2, nidle * NWAVES, lane, 1, S.nM); }
                    __syncthreads();
                }
                if (BOTH(pb + 6)) GRID_BAR();
            }
            if (IN(pb + 7)) { WS_VIEWS();
                const int t = ptid(), lane = t & 63, gw = vcu * NWAVES + __builtin_amdgcn_readfirstlane(t >> 6);
                const int nMtot = __builtin_amdgcn_readfirstlane(tbl[8]), nfull = (nMtot * (DM / 256)) / G, rtf = nfull * G / (DM / 256);
                rows_post_ffn<true, false>((bf16*)(ws_ + WS_XB), P.out, Y, tokinfo, tbl, P.in[17] + layer * DM, nullptr, nullptr, nullptr, nullptr, nullptr, nullptr, lds, t, gw, NGW, lane, (rtf < nMtot) ? 2 : 0, rtf);
            }
        }
    }
#undef IN
#undef BOTH
#undef GRID_BAR
}

__global__ void dbg_dump(const bf16* buf, int pitch, float* out) {
    const size_t i = (size_t)blockIdx.x * blockDim.x + threadIdx.x; const size_t row = i / DM; const int c = (int)(i % DM);
    float s = 0.f; for (int k = c; k < pitch; k += DM) s += bf_lo((unsigned)buf[row * pitch + k]);
    out[i] = s;
}
#ifndef MK_DUMP
#define MK_DUMP 0
#endif
extern "C" void kernel_launch(void* const* d_in, const int* in_sizes, int n_in, void* d_out, int out_size, void* d_ws, size_t ws_size, hipStream_t stream) {
    static int grid = 0;
    if (grid == 0) {
        if (n_in != 25 || in_sizes[0] != T_TOK * DM || out_size != T_TOK * DM || ws_size < WS_END) { fprintf(stderr, "kernel_launch: unexpected problem shape (n_in %d, in0 %d, out %d, ws %zu < %zu)\n", n_in, n_in > 0 ? in_sizes[0] : -1, out_size, ws_size, (size_t)WS_END); grid = -1; return; }
        int dev = 0, cus = 0, per_cu = 0;
        if (hipGetDevice(&dev) != hipSuccess || hipDeviceGetAttribute(&cus, hipDeviceAttributeMultiprocessorCount, dev) != hipSuccess) { grid = -1; return; }
        if (hipFuncSetAttribute((const void*)mk_fwd, hipFuncAttributeMaxDynamicSharedMemorySize, LDS_BYTES) != hipSuccess) { fprintf(stderr, "kernel_launch: hipFuncSetAttribute failed\n"); grid = -1; return; }
        if (hipOccupancyMaxActiveBlocksPerMultiprocessor(&per_cu, (const void*)mk_fwd, NWAVES * 64, LDS_BYTES) != hipSuccess || per_cu < 1) fprintf(stderr, "kernel_launch: occupancy query reports %d\n", per_cu);
        (void)hipGetLastError();
        grid = cus;
    }
    if (grid < 0) return;
    if (hipMemsetAsync((char*)d_ws + WS_CTL, 0, CTL_ZERO_BYTES, stream) != hipSuccess) return;
    Args a{};
    for (int i = 0; i < 25; ++i) a.in[i] = (const float*)d_in[i];
    a.out = (float*)d_out; a.ws = (unsigned char*)d_ws;
#if MK_N_LAUNCHES == 1
    a.ph_lo = 0; a.ph_hi = (N_PHASES < MK_STOP_PHASE) ? N_PHASES : MK_STOP_PHASE;
    hipLaunchKernelGGL(mk_fwd, dim3(grid), dim3(NWAVES * 64), LDS_BYTES, stream, a);
#else
    for (int p = 0; p < N_PHASES && p < MK_STOP_PHASE; ++p) { a.ph_lo = p; a.ph_hi = p + 1; hipLaunchKernelGGL(mk_fwd, dim3(grid), dim3(NWAVES * 64), LDS_BYTES, stream, a); }
    if (MK_DUMP) { const unsigned char* w = (const unsigned char*)d_ws; const bf16* b = nullptr; int pitch = DM;
        if (MK_DUMP == 1) { b = (const bf16*)(w + WS_Z); pitch = ZP; } if (MK_DUMP == 2) { b = (const bf16*)(w + WS_G); pitch = GP; } if (MK_DUMP == 3) b = (const bf16*)(w + WS_O);
        if (MK_DUMP == 4) b = (const bf16*)(w + WS_MG); if (MK_DUMP == 5) b = (const bf16*)(w + WS_MO); if (MK_DUMP == 6) b = (const bf16*)(w + WS_H);
        hipLaunchKernelGGL(dbg_dump, dim3(T_TOK * DM / 256), dim3(256), 0, stream, b, pitch, (float*)d_out); }
#endif
}
```
